# Optimizing an MI355X kernel written in HIP

```python
import math
import jax, jax.numpy as jnp
from jax import lax
import numpy as np

D_MODEL = 2048
BATCH = 1
SEQ = 8192
DEPTH = 1

D_MIX = D_MODEL
ATTN_WIDTH = D_MIX // 2
LRU_WIDTH = D_MIX - ATTN_WIDTH
HEAD_DIM = 64
N_HEADS = ATTN_WIDTH // HEAD_DIM
LRU_BLOCKS = 16
LRU_BLOCK_W = LRU_WIDTH // LRU_BLOCKS
CONV_WIDTH = 4
LRU_C = 8.0
DILATED_PATTERNS = ((128, 1), (512, 4), (2048, 16))
Q_BLOCK = 128
ATTN_SCALE = 1.0 / math.sqrt(HEAD_DIM)
NEG_INF = -1e30
EPS = 1e-6
PROJ_WIDTH = 4 * ATTN_WIDTH + 2 * LRU_WIDTH

kernel_name = "hymba_dilated_attn_rglru_adaln"


def rmsnorm(x, g):
    xf = x.astype(jnp.float32)
    var = jnp.mean(xf * xf, axis=-1, keepdims=True)
    return xf * lax.rsqrt(var + EPS) * g.astype(jnp.float32)


def alibi_slopes(n_heads):
    return 2.0 ** (-8.0 * jnp.arange(1, n_heads + 1, dtype=jnp.float32) / n_heads)


def dilated_attention(q, k, v):
    B, S, _ = q.shape
    q = q.reshape(B, S, N_HEADS, HEAD_DIM)
    k = k.reshape(B, S, N_HEADS, HEAD_DIM)
    v = v.reshape(B, S, N_HEADS, HEAD_DIM)
    slopes = alibi_slopes(N_HEADS)
    nb = S // Q_BLOCK
    q_blocks = q.reshape(B, nb, Q_BLOCK, N_HEADS, HEAD_DIM).transpose(1, 0, 2, 3, 4)
    starts = jnp.arange(nb, dtype=jnp.int32) * Q_BLOCK

    def one_block(args):
        qb, q0 = args
        qb = qb.astype(jnp.float32) * ATTN_SCALE
        t = q0 + jnp.arange(Q_BLOCK, dtype=jnp.int32)
        outs, lses = [], []
        for window, dilation in DILATED_PATTERNS:
            offs = jnp.arange(window // dilation + 1, dtype=jnp.int32) * dilation
            idx = t[:, None] - offs[None, :]
            valid = idx >= 0
            idx = jnp.maximum(idx, 0)
            kg = jnp.take(k, idx, axis=1).astype(jnp.float32)
            vg = jnp.take(v, idx, axis=1).astype(jnp.float32)
            s = jnp.einsum('bqhd,bqnhd->bhqn', qb, kg)
            s = s - slopes[:, None, None] * offs.astype(jnp.float32)[None, None, :]
            s = jnp.where(valid[None, None], s, NEG_INF)
            m = jnp.max(s, axis=-1, keepdims=True)
            p = jnp.exp(s - m)
            l = jnp.sum(p, axis=-1)
            o = jnp.einsum('bhqn,bqnhd->bqhd', p, vg) / jnp.transpose(l, (0, 2, 1))[..., None]
            outs.append(o)
            lses.append(m[..., 0] + jnp.log(l))
        w = jax.nn.softmax(jnp.stack(lses, axis=0), axis=0)
        return jnp.einsum('pbhq,pbqhd->bqhd', w, jnp.stack(outs, axis=0))

    out = lax.map(one_block, (q_blocks, starts))
    return out.transpose(1, 0, 2, 3, 4).reshape(B, S, ATTN_WIDTH)


def rglru_branch(u, conv_w, conv_b, w_rgate, b_rgate, w_igate, b_igate, lru_lambda):
    B, S, W = u.shape
    uf = u.astype(jnp.float32)
    up = jnp.pad(uf, ((0, 0), (CONV_WIDTH - 1, 0), (0, 0)))
    xc = conv_b.astype(jnp.float32)
    for j in range(CONV_WIDTH):
        xc = xc + up[:, j:j + S] * conv_w[j].astype(jnp.float32)
    xb = xc.reshape(B, S, LRU_BLOCKS, LRU_BLOCK_W)
    r = jax.nn.sigmoid(jnp.einsum('bsnk,nkj->bsnj', xb, w_rgate.astype(jnp.float32)) + b_rgate.astype(jnp.float32)).reshape(B, S, W)
    i = jax.nn.sigmoid(jnp.einsum('bsnk,nkj->bsnj', xb, w_igate.astype(jnp.float32)) + b_igate.astype(jnp.float32)).reshape(B, S, W)
    log_a = LRU_C * r * jax.nn.log_sigmoid(lru_lambda.astype(jnp.float32))
    a = jnp.exp(log_a)
    mult = jnp.sqrt(-jnp.expm1(2.0 * log_a))
    b = mult * (i * xc)

    def combine(e1, e2):
        a1, b1 = e1
        a2, b2 = e2
        return a1 * a2, a2 * b1 + b2

    _, h = lax.associative_scan(combine, (a, b), axis=1)
    return h


def setup_inputs(seed: int = 0) -> dict:
    key = jax.random.key(seed)
    ks = jax.random.split(key, 16)
    f32 = jnp.float32
    x = jax.random.normal(ks[0], (BATCH, SEQ, D_MODEL), f32)
    c = jax.random.normal(ks[1], (BATCH, D_MODEL), f32)
    norm_gain = jnp.ones((DEPTH, D_MODEL), f32) + 0.02 * jax.random.normal(ks[2], (DEPTH, D_MODEL), f32)
    w_ada = jax.random.normal(ks[3], (DEPTH, D_MODEL, 3 * D_MODEL), f32) * D_MODEL ** -0.5
    b_ada = 0.01 * jax.random.normal(ks[4], (DEPTH, 3 * D_MODEL), f32)
    w_in = jax.random.normal(ks[5], (DEPTH, D_MODEL, PROJ_WIDTH), f32) * D_MODEL ** -0.5
    conv_w = jax.random.normal(ks[6], (DEPTH, CONV_WIDTH, LRU_WIDTH), f32) * CONV_WIDTH ** -0.5
    conv_b = 0.01 * jax.random.normal(ks[7], (DEPTH, LRU_WIDTH), f32)
    w_rgate = jax.random.normal(ks[8], (DEPTH, LRU_BLOCKS, LRU_BLOCK_W, LRU_BLOCK_W), f32) * LRU_BLOCK_W ** -0.5
    b_rgate = 0.01 * jax.random.normal(ks[9], (DEPTH, LRU_BLOCKS, LRU_BLOCK_W), f32)
    w_igate = jax.random.normal(ks[10], (DEPTH, LRU_BLOCKS, LRU_BLOCK_W, LRU_BLOCK_W), f32) * LRU_BLOCK_W ** -0.5
    b_igate = 0.01 * jax.random.normal(ks[11], (DEPTH, LRU_BLOCKS, LRU_BLOCK_W), f32)
    a0 = jax.random.uniform(ks[12], (DEPTH, LRU_WIDTH), f32, 0.9, 0.999)
    s0 = a0 ** (1.0 / LRU_C)
    lru_lambda = jnp.log(s0) - jnp.log1p(-s0)
    w_out = jax.random.normal(ks[13], (DEPTH, D_MIX, D_MODEL), f32) * D_MIX ** -0.5
    final_gain = jnp.ones((D_MODEL,), f32) + 0.02 * jax.random.normal(ks[14], (D_MODEL,), f32)
    return {"x": x, "c": c, "norm_gain": norm_gain, "w_ada": w_ada, "b_ada": b_ada,
            "w_in": w_in, "conv_w": conv_w, "conv_b": conv_b, "w_rgate": w_rgate,
            "b_rgate": b_rgate, "w_igate": w_igate, "b_igate": b_igate,
            "lru_lambda": lru_lambda, "w_out": w_out, "final_gain": final_gain}


def reference(x, c, norm_gain, w_ada, b_ada, w_in, conv_w, conv_b, w_rgate, b_rgate,
              w_igate, b_igate, lru_lambda, w_out, final_gain):
    y = x.astype(jnp.float32)
    c_act = jax.nn.silu(c.astype(jnp.float32))
    for l in range(DEPTH):
        mod = c_act @ w_ada[l].astype(jnp.float32) + b_ada[l].astype(jnp.float32)
        shift, scale, gate = jnp.split(mod, 3, axis=-1)
        h = rmsnorm(y, norm_gain[l]) * (1.0 + scale[:, None, :]) + shift[:, None, :]
        proj = h @ w_in[l].astype(jnp.float32)
        A = ATTN_WIDTH
        q, k, v, g_attn, u, g_lru = jnp.split(
            proj, [A, 2 * A, 3 * A, 4 * A, 4 * A + LRU_WIDTH], axis=-1)
        attn = dilated_attention(q, k, v)
        lru = rglru_branch(u, conv_w[l], conv_b[l], w_rgate[l], b_rgate[l],
                           w_igate[l], b_igate[l], lru_lambda[l])
        mixed = jnp.concatenate([attn * jax.nn.silu(g_attn), lru * jax.nn.silu(g_lru)], axis=-1)
        y = y + gate[:, None, :] * (mixed @ w_out[l].astype(jnp.float32))
    return rmsnorm(y, final_gain)
```

```cpp
#include <hip/hip_runtime.h>
#include <hip/hip_cooperative_groups.h>
#include <cstdio>
#include <cstdint>
namespace cg = cooperative_groups;

#define LAS __attribute__((address_space(3)))
typedef unsigned short bf16_t;
typedef short bf16x8 __attribute__((ext_vector_type(8)));
typedef short s16x4 __attribute__((ext_vector_type(4)));
typedef float f32x4 __attribute__((ext_vector_type(4)));
typedef float f32x16 __attribute__((ext_vector_type(16)));
typedef unsigned u32x4 __attribute__((ext_vector_type(4)));
typedef unsigned u32x2 __attribute__((ext_vector_type(2)));
typedef float f32x2_t __attribute__((ext_vector_type(2)));
typedef __bf16 bf16x2_t __attribute__((ext_vector_type(2)));
typedef short v4i16_t __attribute__((ext_vector_type(4)));

constexpr int S = 8192, DM = 2048, PW = 6144, AW = 1024, NH = 16;
constexpr float EPS = 1e-6f;
constexpr float LOG2E = 1.4426950408889634f;
constexpr float QSCALE = 0.125f * LOG2E;
constexpr int NWAVES = 8;
constexpr int LDS_BYTES = 147456;
constexpr int NPH = 7;

constexpr size_t MiB = 1u << 20;
constexpr size_t WS_MOD = 1 * MiB;
constexpr size_t WS_WRT = 1 * MiB + 65536;
constexpr size_t WS_WIT = WS_WRT + 131072;
constexpr size_t WS_TOT2 = 1 * MiB + 512 * 1024;
constexpr size_t WS_TOT = 2 * MiB;
constexpr size_t WS_WIN = 4 * MiB;
constexpr size_t WS_WOUT = 28 * MiB;
constexpr size_t WS_H = 36 * MiB;
constexpr size_t WS_PROJ = 68 * MiB;
constexpr size_t PROJ_STRIDE = (size_t)S * 1024;
constexpr size_t WS_OP = 164 * MiB;
constexpr size_t WS_SLOT = 3 * MiB;
constexpr size_t WS_LSE = 212 * MiB;

__device__ __forceinline__ unsigned cvtpk(float lo, float hi) { f32x2_t v = {lo, hi}; bf16x2_t b = __builtin_convertvector(v, bf16x2_t); return __builtin_bit_cast(unsigned, b); }
__device__ __forceinline__ float bf2f(unsigned short u) { return __uint_as_float((unsigned)u << 16); }
__device__ __forceinline__ float bflo(unsigned u) { return __uint_as_float(u << 16); }
__device__ __forceinline__ float bfhi(unsigned u) { return __uint_as_float(u & 0xffff0000u); }
__device__ __forceinline__ float fsigmoid(float x) { return __builtin_amdgcn_rcpf(1.0f + __expf(-x)); }
__device__ __forceinline__ float fsilu(float x) { return x * fsigmoid(x); }
__device__ __forceinline__ float wave_sum(float v) {
#pragma unroll
    for (int o = 1; o < 64; o <<= 1) v += __shfl_xor(v, o);
    return v;
}

namespace pg8 {
#define PG8_LAS __attribute__((address_space(3)))
constexpr int BM = 256, BK = 64, HALF = 128, HTB = HALF * BK * 2, STAGE_BYTES = 8 * HTB, NXCD = 8, WGM = 8;
__host__ __device__ __forceinline__ int lds_byte(int r, int c) { const int st = (r >> 4) * 2 + (c >> 5), rr = r & 15, cc = c & 31, ob = rr * 64 + cc * 2; return st * 1024 + (ob ^ (((ob >> 9) & 1) << 5)); }
__host__ __device__ __forceinline__ void stage_rc(int b, int& R, int& C) { const int st = b / 1024, sb = b % 1024, swz = sb ^ (((sb >> 9) & 1) << 5); R = (st >> 1) * 16 + swz / 64; C = (st & 1) * 32 + (swz % 64) / 2; }
__host__ __device__ __forceinline__ int perm32(int rho) { const int n = rho >> 4, i = rho & 15; return 8 * (i >> 2) + 4 * n + (i & 3); }
struct Unit { int pm, pn; };
struct Gemm { const bf16_t* A; const bf16_t* Bt; int M, N, K; };
struct StaticOrder {
    int nM, nN, nwg, G, c;
    __host__ __device__ void init(int M, int N, int G_, int c_) { nM = M / BM; nN = N / BM; nwg = nM * nN; G = G_; c = c_; }
    __host__ __device__ bool next(int i, Unit& u) const {
        const long L = (long)i * G + c; if (L >= nwg) return false;
        int wgid = (int)L; { const int q = nwg / NXCD, r = nwg % NXCD, xcd = wgid % NXCD, off = wgid / NXCD; wgid = (xcd < r ? xcd * (q + 1) : r * (q + 1) + (xcd - r) * q) + off; }
        const int nig = WGM * nN, gid = wgid / nig, fm = gid * WGM, gsz = (nM - fm) < WGM ? (nM - fm) : WGM;
        u.pm = fm + ((wgid % nig) % gsz); u.pn = (wgid % nig) / gsz; return true;
    }
    __device__ __forceinline__ void a_ready(const Unit&) const {}
    __device__ __forceinline__ void done(const Unit&) const {}
};
__device__ __forceinline__ unsigned cvt_pk_bf16(float lo, float hi) { unsigned r; asm volatile("v_cvt_pk_bf16_f32 %0, %1, %2" : "=v"(r) : "v"(lo), "v"(hi)); return r; }

struct EpiBf16 {
    static constexpr bool PERM = true, AFTER_DRAIN = false;
    bf16_t* O; int ldc; int split_cols; size_t split_stride; float scale0;
    __device__ __forceinline__ void operator()(const f32x4 (&acc)[2][2][4][2], const Unit& u, int wr, int wc, int fr, int fq) const {
        const int row0 = u.pm * BM + wr * 64 + fr; int colt = u.pn * BM;
        float sc = 1.f; const int t = colt / split_cols; colt -= t * split_cols; if (t == 0) sc = scale0;
        const int col0 = colt + wc * 32 + 8 * fq;
        const __amdgpu_buffer_rsrc_t rs = __builtin_amdgcn_make_buffer_rsrc((void*)O, (short)0, (int)(6 * PROJ_STRIDE * 2), 0x00020000);
        const unsigned tb = (unsigned)((size_t)t * split_stride * 2);
#pragma unroll
        for (int ai = 0; ai < 2; ++ai)
#pragma unroll
            for (int m = 0; m < 4; ++m) { const unsigned ro = tb + (unsigned)(((row0 + ai * HALF + m * 16) * ldc + col0) * 2);
#pragma unroll
                for (int bj = 0; bj < 2; ++bj) { f32x4 v0 = acc[ai][bj][m][0] * sc, v1 = acc[ai][bj][m][1] * sc;
                    u32x4 w; w.x = cvt_pk_bf16(v0[0], v0[1]); w.y = cvt_pk_bf16(v0[2], v0[3]); w.z = cvt_pk_bf16(v1[0], v1[1]); w.w = cvt_pk_bf16(v1[2], v1[3]);
                    __builtin_amdgcn_raw_buffer_store_b128(w, rs, (int)(ro + bj * HALF * 2), 0, 16); } }
    }
    __device__ __forceinline__ void fused(f32x4 (&)[2][2][4][2], const Unit&, int, int, int, int, PG8_LAS unsigned char*, int, int) const {}
};
struct EpiResGate {
    static constexpr bool PERM = false, AFTER_DRAIN = false;
    const float* x; const float* gate; float* out; int ldc;
    __device__ __forceinline__ void operator()(const f32x4 (&acc)[2][2][4][2], const Unit& u, int wr, int wc, int fr, int fq) const {
        const int col0 = u.pn * BM + wc * 32 + 4 * fq;
        f32x4 gv[2][2];
#pragma unroll
        for (int bj = 0; bj < 2; ++bj)
#pragma unroll
            for (int n = 0; n < 2; ++n) gv[bj][n] = *(const f32x4*)(gate + col0 + bj * HALF + n * 16);
#pragma unroll
        for (int ai = 0; ai < 2; ++ai)
#pragma unroll
            for (int m = 0; m < 4; ++m) { const size_t off = (size_t)(u.pm * BM + ai * HALF + wr * 64 + m * 16 + fr) * ldc + col0;
#pragma unroll
                for (int bj = 0; bj < 2; ++bj)
#pragma unroll
                    for (int n = 0; n < 2; ++n) { const f32x4 xv = *(const f32x4*)(x + off + bj * HALF + n * 16);
                        *(f32x4*)(out + off + bj * HALF + n * 16) = xv + gv[bj][n] * acc[ai][bj][m][n]; } }
    }
    __device__ __forceinline__ void fused(f32x4 (&)[2][2][4][2], const Unit&, int, int, int, int, PG8_LAS unsigned char*, int, int) const {}
};

struct EpiFinal {
    static constexpr bool PERM = false, AFTER_DRAIN = true;
    const float* x; const float* gate; const float* fg; float* out; int ldc; float* slots; unsigned* cnt;
    __device__ __forceinline__ void operator()(const f32x4 (&)[2][2][4][2], const Unit&, int, int, int, int) const {}
    __device__ __forceinline__ void fused(f32x4 (&acc)[2][2][4][2], const Unit& u, int wr, int wc, int fr, int fq, PG8_LAS unsigned char* lds, int wid, int lane) const {
        const int col0 = u.pn * BM + wc * 32 + 4 * fq;
        PG8_LAS float* P = (PG8_LAS float*)lds;
        PG8_LAS float* Sr = (PG8_LAS float*)(lds + 4096);
        {
        f32x4 gv[2][2];
#pragma unroll
        for (int bj = 0; bj < 2; ++bj)
#pragma unroll
            for (int n = 0; n < 2; ++n) gv[bj][n] = *(const f32x4*)(gate + col0 + bj * HALF + n * 16);
#pragma unroll
        for (int ai = 0; ai < 2; ++ai)
#pragma unroll
            for (int m = 0; m < 4; ++m) { const int rl = ai * HALF + wr * 64 + m * 16 + fr; const size_t off = (size_t)(u.pm * BM + rl) * ldc + col0;
                float ss = 0.f;
#pragma unroll
                for (int bj = 0; bj < 2; ++bj)
#pragma unroll
                    for (int n = 0; n < 2; ++n) { const f32x4 xv = __builtin_nontemporal_load((const f32x4*)(x + off + bj * HALF + n * 16)); const f32x4 y = xv + gv[bj][n] * acc[ai][bj][m][n];
                        acc[ai][bj][m][n] = y; ss += (y[0] * y[0] + y[1] * y[1]) + (y[2] * y[2] + y[3] * y[3]); }
                ss += __shfl_xor(ss, 16); ss += __shfl_xor(ss, 32);
                if (fq == 0) P[rl * 4 + wc] = ss; }
        }
        asm volatile("s_waitcnt lgkmcnt(0)" ::: "memory"); __builtin_amdgcn_s_barrier(); asm volatile("" ::: "memory");
        const int row = wid * 32 + (lane & 31);
        if (lane < 32) { const float t = (P[row * 4 + 0] + P[row * 4 + 1]) + (P[row * 4 + 2] + P[row * 4 + 3]);
            __hip_atomic_store(slots + (size_t)(u.pm * BM + row) * 8 + u.pn, t, __ATOMIC_RELAXED, __HIP_MEMORY_SCOPE_AGENT); }
        asm volatile("s_waitcnt vmcnt(0)" ::: "memory");
        if (lane == 0) __hip_atomic_fetch_add(cnt + 64 * u.pm, 1u, __ATOMIC_RELAXED, __HIP_MEMORY_SCOPE_AGENT);
        if (wid == 0) {
            for (unsigned spins = 0; spins < (1u << 22); ++spins) {
                if ((unsigned)__builtin_amdgcn_readfirstlane(__hip_atomic_load(cnt + 64 * u.pm, __ATOMIC_RELAXED, __HIP_MEMORY_SCOPE_AGENT)) >= 64u) break;
                __builtin_amdgcn_s_sleep(2);
            }
            __builtin_amdgcn_fence(__ATOMIC_ACQUIRE, "agent");
        }
        asm volatile("s_waitcnt vmcnt(0) lgkmcnt(0)" ::: "memory"); __builtin_amdgcn_s_barrier(); asm volatile("" ::: "memory");
        if (lane < 32) { const float* sl = slots + (size_t)(u.pm * BM + row) * 8; float t = 0.f;
#pragma unroll
            for (int k = 0; k < 8; ++k) t += __hip_atomic_load(sl + k, __ATOMIC_RELAXED, __HIP_MEMORY_SCOPE_AGENT);
            Sr[row] = rsqrtf(t * (1.0f / 2048.0f) + 1e-6f); }
        asm volatile("s_waitcnt vmcnt(0) lgkmcnt(0)" ::: "memory"); __builtin_amdgcn_s_barrier(); asm volatile("" ::: "memory");
        f32x4 fv[2][2];
#pragma unroll
        for (int bj = 0; bj < 2; ++bj)
#pragma unroll
            for (int n = 0; n < 2; ++n) fv[bj][n] = *(const f32x4*)(fg + col0 + bj * HALF + n * 16);
#pragma unroll
        for (int ai = 0; ai < 2; ++ai)
#pragma unroll
            for (int m = 0; m < 4; ++m) { const int rl = ai * HALF + wr * 64 + m * 16 + fr; const size_t off = (size_t)(u.pm * BM + rl) * ldc + col0; const float rstd = Sr[rl];
#pragma unroll
                for (int bj = 0; bj < 2; ++bj)
#pragma unroll
                    for (int n = 0; n < 2; ++n) __builtin_nontemporal_store(acc[ai][bj][m][n] * rstd * fv[bj][n], (f32x4*)(out + off + bj * HALF + n * 16)); }
    }
};

template <class Epi, class Sched, bool ALIGN_EPI = false, bool SP2 = false>
__device__ __forceinline__ void gemm_phase(PG8_LAS unsigned char* lds, const Gemm g, const Sched& S, const Epi& E) {
    const int tid = threadIdx.x, wid = __builtin_amdgcn_readfirstlane(tid >> 6), lane = tid & 63, wr = wid >> 2, wc = wid & 3, fr = lane & 15, fq = lane >> 4;
    const int K = g.K, nt = K / BK;
    unsigned voffA[2], voffB[2];
#pragma unroll
    for (int i = 0; i < 2; ++i) { int R, C; stage_rc(tid * 16 + i * 8192, R, C); const int Rb = Epi::PERM ? ((R & ~31) + perm32(R & 31)) : R;
        voffA[i] = (unsigned)(R * K + C) * 2u; voffB[i] = (unsigned)(Rb * K + C) * 2u; }
    const size_t kstep = (size_t)(BK * 2);
    const size_t hstep = (size_t)HALF * K * 2;
    const size_t tstep = 2 * hstep;
    const unsigned ldsw = (unsigned)wid * 1024u;
    const int aoff = lds_byte(wr * 64 + fr, fq * 8), boff = lds_byte(wc * 32 + fr, fq * 8);
#define PG8_SA(b, h) (((b) * 2 + (h)) * HTB)
#define PG8_SB(b, h) ((4 + (b) * 2 + (h)) * HTB)
#define PG8_STAGE(bufoff, gbase, voff) do { _Pragma("unroll") for (int _i = 0; _i < 2; ++_i) \
        __builtin_amdgcn_global_load_lds((const unsigned*)((const char*)(gbase) + (voff)[_i]), (PG8_LAS unsigned*)(lds + (bufoff) + ldsw + _i * 8192), 16, 0, 0); } while (0)
#define PG8_LDA(dst, b, h) do { _Pragma("unroll") for (int m = 0; m < 4; ++m) _Pragma("unroll") for (int k = 0; k < 2; ++k) dst[m][k] = *(const PG8_LAS bf16x8*)(lds + PG8_SA(b, h) + aoff + m * 2048 + k * 1024); } while (0)
#define PG8_LDB(dst, b, h) do { _Pragma("unroll") for (int n = 0; n < 2; ++n) _Pragma("unroll") for (int k = 0; k < 2; ++k) dst[n][k] = *(const PG8_LAS bf16x8*)(lds + PG8_SB(b, h) + boff + n * 2048 + k * 1024); } while (0)
#define PG8_MMA(ai, bj, At, Bt) do { __builtin_amdgcn_s_setprio(1); _Pragma("unroll") for (int m = 0; m < 4; ++m) _Pragma("unroll") for (int n = 0; n < 2; ++n) _Pragma("unroll") for (int k = 0; k < 2; ++k) \
        acc[ai][bj][m][n] = __builtin_amdgcn_mfma_f32_16x16x32_bf16(Bt[n][k], At[m][k], acc[ai][bj][m][n], 0, 0, 0); __builtin_amdgcn_s_setprio(0); } while (0)
#define PG8_WAIT_V(n) asm volatile("s_waitcnt vmcnt(" #n ")" ::: "memory")
#define PG8_WAIT_L(n) asm volatile("s_waitcnt lgkmcnt(" #n ")" ::: "memory")
#define PG8_BAR __builtin_amdgcn_s_barrier()
#define PG8_SCHED __builtin_amdgcn_sched_barrier(0)
    Unit cur, nxt; int ui = 0;
    if (!S.next(0, cur)) return;
    f32x4 acc[2][2][4][2];
#pragma unroll
    for (int a = 0; a < 2; ++a)
#pragma unroll
        for (int b = 0; b < 2; ++b)
#pragma unroll
            for (int m = 0; m < 4; ++m)
#pragma unroll
                for (int n = 0; n < 2; ++n) acc[a][b][m][n] = (f32x4){0.f, 0.f, 0.f, 0.f};
    bf16x8 At[4][2], B0[2][2], B1[2][2];
    const char* cA = (const char*)g.A + (size_t)cur.pm * tstep; const char* cB = (const char*)g.Bt + (size_t)cur.pn * tstep;
    S.a_ready(cur);
    if constexpr (SP2) {
        PG8_STAGE(PG8_SB(0, 0), cB, voffB); PG8_STAGE(PG8_SB(0, 1), cB + hstep, voffB); PG8_STAGE(PG8_SA(0, 0), cA, voffA); PG8_STAGE(PG8_SA(0, 1), cA + hstep, voffA);
        if (wr == 1) PG8_BAR;
        PG8_WAIT_V(2); PG8_BAR;
        PG8_STAGE(PG8_SB(1, 0), cB + kstep, voffB); PG8_STAGE(PG8_SA(1, 0), cA + kstep, voffA); PG8_STAGE(PG8_SB(1, 1), cB + hstep + kstep, voffB);
        PG8_WAIT_V(6); PG8_BAR;
    } else {
        PG8_STAGE(PG8_SB(0, 0), cB, voffB); PG8_STAGE(PG8_SA(0, 0), cA, voffA); PG8_STAGE(PG8_SB(0, 1), cB + hstep, voffB); PG8_STAGE(PG8_SA(0, 1), cA + hstep, voffA);
        if (wr == 1) PG8_BAR;
        PG8_WAIT_V(4); PG8_BAR;
        PG8_STAGE(PG8_SB(1, 0), cB + kstep, voffB); PG8_STAGE(PG8_SA(1, 0), cA + kstep, voffA); PG8_STAGE(PG8_SB(1, 1), cB + hstep + kstep, voffB);
        PG8_WAIT_V(6); PG8_BAR;
    }
    for (;;) {
        const bool has_next = S.next(ui + 1, nxt);
        const char* nA = has_next ? (const char*)g.A + (size_t)nxt.pm * tstep : cA; const char* nB = has_next ? (const char*)g.Bt + (size_t)nxt.pn * tstep : cB;
        for (int t = 0; t < nt; t += 2) {
            const bool last = (t == nt - 2);
            const char* a1 = cA + (size_t)(t + 1) * kstep;
            const char* a2 = last ? nA : cA + (size_t)(t + 2) * kstep; const char* b2 = last ? nB : cB + (size_t)(t + 2) * kstep;
            const char* a3 = a2 + kstep; const char* b3 = b2 + kstep;
            if (last && has_next) S.a_ready(nxt);
            if constexpr (SP2) {
            PG8_LDB(B0, 0, 0); PG8_LDB(B1, 0, 1); PG8_SCHED; PG8_LDA(At, 0, 0); PG8_STAGE(PG8_SA(1, 1), a1 + hstep, voffA);
            PG8_WAIT_V(8); PG8_WAIT_L(0); PG8_BAR; PG8_MMA(0, 0, At, B0); PG8_MMA(0, 1, At, B1); PG8_BAR; PG8_SCHED;
            PG8_LDA(At, 0, 1); PG8_STAGE(PG8_SB(0, 0), b2, voffB); PG8_STAGE(PG8_SB(0, 1), b2 + hstep, voffB); PG8_STAGE(PG8_SA(0, 0), a2, voffA);
            PG8_WAIT_V(8); PG8_WAIT_L(0); PG8_BAR; PG8_MMA(1, 0, At, B0); PG8_MMA(1, 1, At, B1); PG8_BAR; PG8_SCHED;
            PG8_LDB(B0, 1, 0); PG8_LDB(B1, 1, 1); PG8_SCHED; PG8_LDA(At, 1, 0); PG8_STAGE(PG8_SA(0, 1), a2 + hstep, voffA);
            PG8_WAIT_V(8); PG8_WAIT_L(0); PG8_BAR; PG8_MMA(0, 0, At, B0); PG8_MMA(0, 1, At, B1); PG8_BAR; PG8_SCHED;
            PG8_LDA(At, 1, 1); PG8_STAGE(PG8_SB(1, 0), b3, voffB); PG8_STAGE(PG8_SB(1, 1), b3 + hstep, voffB); PG8_STAGE(PG8_SA(1, 0), a3, voffA);
            PG8_WAIT_V(8); PG8_WAIT_L(0); PG8_BAR; PG8_MMA(1, 0, At, B0); PG8_MMA(1, 1, At, B1); PG8_BAR; PG8_SCHED;
            } else {
            PG8_LDB(B0, 0, 0); PG8_SCHED; PG8_LDA(At, 0, 0); PG8_STAGE(PG8_SA(1, 1), a1 + hstep, voffA);
            PG8_WAIT_L(8); PG8_BAR; PG8_WAIT_L(0); PG8_MMA(0, 0, At, B0); PG8_BAR; PG8_SCHED;
            PG8_LDB(B1, 0, 1); PG8_STAGE(PG8_SB(0, 0), b2, voffB);
            PG8_BAR; PG8_WAIT_L(0); PG8_MMA(0, 1, At, B1); PG8_BAR;
            PG8_LDA(At, 0, 1); PG8_STAGE(PG8_SA(0, 0), a2, voffA);
            PG8_BAR; PG8_WAIT_L(0); PG8_MMA(1, 0, At, B0); PG8_BAR; PG8_SCHED;
            PG8_STAGE(PG8_SB(0, 1), b2 + hstep, voffB);
            PG8_WAIT_V(6); PG8_BAR; PG8_MMA(1, 1, At, B1); PG8_BAR;
            PG8_LDB(B0, 1, 0); PG8_SCHED; PG8_LDA(At, 1, 0); PG8_STAGE(PG8_SA(0, 1), a2 + hstep, voffA);
            PG8_WAIT_L(8); PG8_BAR; PG8_WAIT_L(0); PG8_MMA(0, 0, At, B0); PG8_BAR; PG8_SCHED;
            PG8_LDB(B1, 1, 1); PG8_STAGE(PG8_SB(1, 0), b3, voffB);
            PG8_BAR; PG8_WAIT_L(0); PG8_MMA(0, 1, At, B1); PG8_BAR;
            PG8_LDA(At, 1, 1); PG8_STAGE(PG8_SA(1, 0), a3, voffA);
            PG8_BAR; PG8_WAIT_L(0); PG8_MMA(1, 0, At, B0); PG8_BAR; PG8_SCHED;
            PG8_STAGE(PG8_SB(1, 1), b3 + hstep, voffB);
            PG8_WAIT_V(6); PG8_BAR; PG8_MMA(1, 1, At, B1); PG8_BAR;
            }
        }
        if constexpr (ALIGN_EPI) { if (wr == 0) PG8_BAR; }
        if constexpr (!Epi::AFTER_DRAIN) { E(acc, cur, wr, wc, fr, fq); S.done(cur); }
        if (!has_next) break;
#pragma unroll
        for (int a = 0; a < 2; ++a)
#pragma unroll
            for (int b = 0; b < 2; ++b)
#pragma unroll
                for (int m = 0; m < 4; ++m)
#pragma unroll
                    for (int n = 0; n < 2; ++n) acc[a][b][m][n] = (f32x4){0.f, 0.f, 0.f, 0.f};
        cur = nxt; cA = nA; cB = nB; ++ui;
        if constexpr (ALIGN_EPI) { if (wr == 1) PG8_BAR; }
    }
    PG8_WAIT_V(0);
    if constexpr (!ALIGN_EPI) { if (wr == 0) PG8_BAR; }
    PG8_BAR;
    if constexpr (Epi::AFTER_DRAIN) { E.fused(acc, cur, wr, wc, fr, fq, lds, wid, lane); S.done(cur); }
#undef PG8_SA
#undef PG8_SB
#undef PG8_STAGE
#undef PG8_LDA
#undef PG8_LDB
#undef PG8_MMA
#undef PG8_WAIT_V
#undef PG8_WAIT_L
#undef PG8_BAR
#undef PG8_SCHED
}
}

#define LDS_WAIT() asm volatile("s_waitcnt lgkmcnt(0)" ::: "memory")
#define MFMA32(a, b, c) __builtin_amdgcn_mfma_f32_32x32x16_bf16((a), (b), (c), 0, 0, 0)

__device__ __forceinline__ void transpose_item(const float* W, int K, int N, bf16_t* WT, LAS float* scr, int item, int lane) {
    const int nblk = N / 32, kb = item / nblk, nb = item % nblk, k0 = 64 * kb, n0 = 32 * nb;
    { const int kr = lane >> 3, c4 = lane & 7; f32x4 v[8];
#pragma unroll
      for (int i = 0; i < 8; ++i) v[i] = __builtin_nontemporal_load((const f32x4*)(W + (size_t)(k0 + 8 * i + kr) * N + n0 + 4 * c4));
#pragma unroll
      for (int i = 0; i < 8; ++i) { LAS float* d = scr + (8 * i + kr) * 33 + 4 * c4; d[0] = v[i][0]; d[1] = v[i][1]; d[2] = v[i][2]; d[3] = v[i][3]; } }
    LDS_WAIT();
    const int c = lane & 7;
#pragma unroll
    for (int j = 0; j < 4; ++j) { const int n = (lane >> 3) + 8 * j; const LAS float* s = scr + (8 * c) * 33 + n;
        u32x4 o; o.x = cvtpk(s[0 * 33], s[1 * 33]); o.y = cvtpk(s[2 * 33], s[3 * 33]); o.z = cvtpk(s[4 * 33], s[5 * 33]); o.w = cvtpk(s[6 * 33], s[7 * 33]);
        *(u32x4*)(WT + (size_t)(n0 + n) * K + k0 + 8 * c) = o; }
    LDS_WAIT();
}

__device__ __forceinline__ void attn_phase(LAS unsigned char* lds, const bf16_t* __restrict__ Q, const bf16_t* __restrict__ Kb, const bf16_t* __restrict__ Vb,
                                           bf16_t* __restrict__ OPB, float* __restrict__ LSEB, unsigned* qctr, int wave, int lane, int tid) {
    const int n = lane & 31, hh = lane >> 5;
    const int prow = tid >> 3, pch = tid & 7;
    unsigned pkw[6];
#pragma unroll
    for (int i = 0; i < 6; ++i) { const int r384 = prow + 64 * i, j = r384 >> 5, row = r384 & 31; pkw[i] = j * 8192 + row * 128; }
    const unsigned kswz = (unsigned)((pch ^ ((prow >> 1) & 7)) << 4), vswz = 4096u + (unsigned)((pch ^ (((prow >> 1) & 1) << 2)) << 4);
    unsigned kr[4], vb[2];
#pragma unroll
    for (int ks = 0; ks < 4; ++ks) kr[ks] = n * 128 + (((2 * ks + hh) ^ ((n >> 1) & 7)) << 4);
    { const int gl = (lane >> 4) & 1, i16 = lane & 15, q = i16 >> 2, p = i16 & 3; const int row0 = 4 * hh + q, cb = 2 * gl + (p >> 1), sw = ((q >> 1) & 1) << 2;
#pragma unroll
      for (int dt = 0; dt < 2; ++dt) vb[dt] = 4096 + row0 * 128 + (((cb + 4 * dt) ^ sw) << 4) + 8 * (p & 1); }
    const bf16x8 ones = (bf16x8){0x3F80, 0x3F80, 0x3F80, 0x3F80, 0x3F80, 0x3F80, 0x3F80, 0x3F80};
    u32x4 pk[6], pv[6]; bf16x8 pq[4];
#define ATT_DECODE(bu_) const int p_ = (bu_) >> 9, rem_ = (bu_) & 511, h_ = rem_ >> 5, i8_ = rem_ & 31; const int dsh_ = p_ == 0 ? 4 : (p_ == 1 ? 2 : 0), gsh_ = 8 - dsh_; \
        const int rho_ = (i8_ * 8) >> gsh_, grp0_ = (i8_ * 8) & ((1 << gsh_) - 1);
#define ATT_FETCH(bu_) do { ATT_DECODE(bu_) \
        _Pragma("unroll") for (int i = 0; i < 6; ++i) { const int kp = 32 * (grp0_ - 4) + prow + 64 * i; pk[i] = (u32x4){0u, 0u, 0u, 0u}; pv[i] = pk[i]; \
            if (kp >= 0) { const size_t o_ = ((size_t)rho_ + ((size_t)kp << dsh_)) * 1024 + h_ * 64 + 8 * pch; pk[i] = *(const u32x4*)(Kb + o_); pv[i] = *(const u32x4*)(Vb + o_); } } \
        { const int tq_ = rho_ + ((32 * (grp0_ + wave) + n) << dsh_); const bf16_t* qp_ = Q + (size_t)tq_ * 1024 + h_ * 64 + 8 * hh; \
          _Pragma("unroll") for (int ks = 0; ks < 4; ++ks) pq[ks] = *(const bf16x8*)(qp_ + 16 * ks); } } while (0)
    volatile LAS int* slot = (volatile LAS int*)(lds + 98304);
    if (tid == 0) slot[0] = (int)__hip_atomic_fetch_add(qctr, 1u, __ATOMIC_RELAXED, __HIP_MEMORY_SCOPE_AGENT);
    asm volatile("s_waitcnt vmcnt(0) lgkmcnt(0)" ::: "memory"); __builtin_amdgcn_s_barrier(); asm volatile("" ::: "memory");
    int bu = slot[0];
    if (bu < 1536) ATT_FETCH(bu);
    while (bu < 1536) {
        ATT_DECODE(bu)
        asm volatile("s_waitcnt lgkmcnt(0)" ::: "memory"); __builtin_amdgcn_s_barrier();
#pragma unroll
        for (int i = 0; i < 6; ++i) { *(LAS u32x4*)(lds + pkw[i] + kswz) = pk[i]; *(LAS u32x4*)(lds + pkw[i] + vswz) = pv[i]; }
        bf16x8 qf[4];
#pragma unroll
        for (int ks = 0; ks < 4; ++ks) qf[ks] = pq[ks];
        if (tid == 0) { slot[0] = (int)__hip_atomic_fetch_add(qctr, 1u, __ATOMIC_RELAXED, __HIP_MEMORY_SCOPE_AGENT); asm volatile("s_waitcnt vmcnt(0)" ::: "memory"); }
        asm volatile("s_waitcnt lgkmcnt(0)" ::: "memory"); __builtin_amdgcn_s_barrier(); asm volatile("" ::: "memory");
        const int nbu = slot[0];
        if (nbu < 1536) ATT_FETCH(nbu);
        const int grp = grp0_ + wave;
        const int tq = rho_ + ((32 * grp + n) << dsh_);
        const float sd = __builtin_amdgcn_exp2f(-0.5f * (float)(h_ + 1)) * LOG2E * (float)(1 << dsh_);
        const float sd32 = 32.0f * sd;
        f32x16 o0, o1, lacc, aci;
#pragma unroll
        for (int i = 0; i < 16; ++i) { o0[i] = 0.f; o1[i] = 0.f; lacc[i] = 0.f; aci[i] = sd * (float)((i & 3) + 8 * (i >> 2) + 4 * hh); }
        float m = -1e30f;
        const int ktmin = grp >= 4 ? 0 : 4 - grp;
        LAS unsigned char* wt = lds + wave * 8192;
#define ATT_TR(addr) __builtin_amdgcn_ds_read_tr16_b64_v4i16((LAS v4i16_t*)(addr))
#define ATT_PV2(tb, pf0, pf1) do { \
        const v4i16_t l00 = ATT_TR((tb) + vb[0]), h00 = ATT_TR((tb) + vb[0] + 1024), l01 = ATT_TR((tb) + vb[1]), h01 = ATT_TR((tb) + vb[1] + 1024); \
        const v4i16_t l10 = ATT_TR((tb) + 2048 + vb[0]), h10 = ATT_TR((tb) + 2048 + vb[0] + 1024), l11 = ATT_TR((tb) + 2048 + vb[1]), h11 = ATT_TR((tb) + 2048 + vb[1] + 1024); \
        o0 = MFMA32(__builtin_shufflevector(l00, h00, 0, 1, 2, 3, 4, 5, 6, 7), pf0, o0); o1 = MFMA32(__builtin_shufflevector(l01, h01, 0, 1, 2, 3, 4, 5, 6, 7), pf0, o1); lacc = MFMA32(ones, pf0, lacc); \
        o0 = MFMA32(__builtin_shufflevector(l10, h10, 0, 1, 2, 3, 4, 5, 6, 7), pf1, o0); o1 = MFMA32(__builtin_shufflevector(l11, h11, 0, 1, 2, 3, 4, 5, 6, 7), pf1, o1); lacc = MFMA32(ones, pf1, lacc); } while (0)
        for (int kt = 4; kt >= ktmin; kt -= 2) {
            const bool hasB = (kt - 1 >= ktmin);
            LAS unsigned char* tA = wt + kt * 8192; LAS unsigned char* tB = tA - 8192;
            f32x16 x0 = aci, x1 = aci;
#pragma unroll
            for (int ks = 0; ks < 4; ++ks) { const bf16x8 kf = *(const LAS bf16x8*)(tA + kr[ks]); x0 = MFMA32(kf, qf[ks], x0); }
            if (hasB) {
#pragma unroll
                for (int ks = 0; ks < 4; ++ks) { const bf16x8 kf = *(const LAS bf16x8*)(tB + kr[ks]); x1 = MFMA32(kf, qf[ks], x1); }
            } else {
#pragma unroll
                for (int rg = 0; rg < 16; ++rg) x1[rg] = -INFINITY;
            }
            if (kt == 4) {
#pragma unroll
                for (int rg = 0; rg < 16; ++rg) { const int cr = (rg & 3) + 8 * (rg >> 2) + 4 * hh; x0[rg] = (cr <= n) ? x0[rg] : -INFINITY; }
            } else if (kt == 0) {
#pragma unroll
                for (int rg = 0; rg < 16; ++rg) { const int cr = (rg & 3) + 8 * (rg >> 2) + 4 * hh; x0[rg] = (cr >= n) ? x0[rg] : -INFINITY; }
            }
            float tmax = fmaxf(fmaxf(x0[0], x0[1]), fmaxf(x0[2], x0[3])), tmb = fmaxf(fmaxf(x1[0], x1[1]), fmaxf(x1[2], x1[3]));
#pragma unroll
            for (int rg = 4; rg < 16; rg += 4) { tmax = fmaxf(tmax, fmaxf(fmaxf(x0[rg], x0[rg + 1]), fmaxf(x0[rg + 2], x0[rg + 3]))); tmb = fmaxf(tmb, fmaxf(fmaxf(x1[rg], x1[rg + 1]), fmaxf(x1[rg + 2], x1[rg + 3]))); }
            tmax = fmaxf(tmax, tmb - sd32);
            { auto rr = __builtin_amdgcn_permlane32_swap(__float_as_uint(tmax), __float_as_uint(tmax), false, false);
              tmax = fmaxf(__uint_as_float(rr[0]), __uint_as_float(rr[1])); }
            const float c0 = sd32 * (float)kt;
            const float mn = fmaxf(m, tmax + c0);
            if (__builtin_amdgcn_ballot_w64(mn > m) != 0ull) {
                const float alpha = __builtin_amdgcn_exp2f(m - mn);
#pragma unroll
                for (int i = 0; i < 16; ++i) { o0[i] *= alpha; o1[i] *= alpha; lacc[i] *= alpha; }
                m = mn;
            }
            const float mm = m - c0, mmB = mm + sd32;
            bf16x8 pA[2], pB[2];
#pragma unroll
            for (int s2 = 0; s2 < 2; ++s2) { u32x4 pw;
                pw.x = cvtpk(__builtin_amdgcn_exp2f(x0[8 * s2] - mm), __builtin_amdgcn_exp2f(x0[8 * s2 + 1] - mm)); pw.y = cvtpk(__builtin_amdgcn_exp2f(x0[8 * s2 + 2] - mm), __builtin_amdgcn_exp2f(x0[8 * s2 + 3] - mm));
                pw.z = cvtpk(__builtin_amdgcn_exp2f(x0[8 * s2 + 4] - mm), __builtin_amdgcn_exp2f(x0[8 * s2 + 5] - mm)); pw.w = cvtpk(__builtin_amdgcn_exp2f(x0[8 * s2 + 6] - mm), __builtin_amdgcn_exp2f(x0[8 * s2 + 7] - mm));
                pA[s2] = __builtin_bit_cast(bf16x8, pw); }
            ATT_PV2(tA, pA[0], pA[1]);
            if (hasB) {
#pragma unroll
                for (int s2 = 0; s2 < 2; ++s2) { u32x4 pw;
                    pw.x = cvtpk(__builtin_amdgcn_exp2f(x1[8 * s2] - mmB), __builtin_amdgcn_exp2f(x1[8 * s2 + 1] - mmB)); pw.y = cvtpk(__builtin_amdgcn_exp2f(x1[8 * s2 + 2] - mmB), __builtin_amdgcn_exp2f(x1[8 * s2 + 3] - mmB));
                    pw.z = cvtpk(__builtin_amdgcn_exp2f(x1[8 * s2 + 4] - mmB), __builtin_amdgcn_exp2f(x1[8 * s2 + 5] - mmB)); pw.w = cvtpk(__builtin_amdgcn_exp2f(x1[8 * s2 + 6] - mmB), __builtin_amdgcn_exp2f(x1[8 * s2 + 7] - mmB));
                    pB[s2] = __builtin_bit_cast(bf16x8, pw); }
                ATT_PV2(tB, pB[0], pB[1]);
            }
        }
#undef ATT_PV2
#undef ATT_TR
        const float lt = lacc[0];
        const float inv = __builtin_amdgcn_rcpf(lt);
        bf16_t* OP = OPB + (size_t)p_ * PROJ_STRIDE; float* LSE = LSEB + (size_t)p_ * S * 16;
        if (hh == 0) LSE[(size_t)tq * 16 + h_] = m + __builtin_amdgcn_logf(lt) - sd * (float)(n + 128);
        u32x2 pk8[8];
#pragma unroll
        for (int dt = 0; dt < 2; ++dt)
#pragma unroll
            for (int g = 0; g < 4; ++g) {
                float v0, v1, v2, v3;
                if (dt == 0) { v0 = o0[4 * g]; v1 = o0[4 * g + 1]; v2 = o0[4 * g + 2]; v3 = o0[4 * g + 3]; } else { v0 = o1[4 * g]; v1 = o1[4 * g + 1]; v2 = o1[4 * g + 2]; v3 = o1[4 * g + 3]; }
                pk8[4 * dt + g].x = cvtpk(v0 * inv, v1 * inv); pk8[4 * dt + g].y = cvtpk(v2 * inv, v3 * inv); }
        bf16_t* orow = OP + (size_t)tq * 1024 + h_ * 64 + 8 * hh;
#pragma unroll
        for (int k = 0; k < 8; k += 2) {
            auto rx = __builtin_amdgcn_permlane32_swap(pk8[k].x, pk8[k + 1].x, false, false);
            auto ry = __builtin_amdgcn_permlane32_swap(pk8[k].y, pk8[k + 1].y, false, false);
            u32x4 w; w.x = rx[0]; w.y = ry[0]; w.z = rx[1]; w.w = ry[1];
            asm volatile("global_store_dwordx4 %0, %1, off sc1\n\ts_nop 1" :: "v"(orow + 8 * k), "v"(w) : "memory"); }
            bu = nbu;
    }
#undef ATT_DECODE
#undef ATT_FETCH
    asm volatile("s_waitcnt lgkmcnt(0)" ::: "memory"); __builtin_amdgcn_s_barrier();
}

constexpr int LRU_WL = 17408;
__device__ __forceinline__ void lru_unit(LAS unsigned char* wl, const bf16_t* __restrict__ U, const bf16_t* __restrict__ GL, const bf16_t* __restrict__ WRT, const bf16_t* __restrict__ WIT,
                                         const float* __restrict__ conv_w, const float* __restrict__ conv_b, const float* __restrict__ b_r, const float* __restrict__ b_i,
                                         const float* __restrict__ lam, unsigned long long* TOT, bf16_t* __restrict__ MX, int c, int nb, int lane) {
    unsigned long long* TOT2 = TOT - (WS_TOT - WS_TOT2) / 8;
    const int t0 = 64 * c, ch0 = 64 * nb;
    const int rs = lane >> 3, chn = lane & 7;
    LAS unsigned char* xcb = wl + 9216;
#pragma unroll
    for (int i = 0; i < 9; ++i) { const int row = 8 * i + rs; const int tok = t0 - 3 + row;
        u32x4 v = (u32x4){0u, 0u, 0u, 0u};
        if (row < 67 && tok >= 0) v = __builtin_nontemporal_load((const u32x4*)(U + (size_t)tok * 1024 + ch0 + 8 * chn));
        *(LAS u32x4*)(wl + row * 128 + chn * 16) = v; }
    {
    float cw[4][8], cbv[8];
    { const float* wp = conv_w + ch0 + 8 * chn;
#pragma unroll
      for (int j = 0; j < 4; ++j) { const f32x4 a = *(const f32x4*)(wp + j * 1024), b = *(const f32x4*)(wp + j * 1024 + 4);
          cw[j][0] = a[0]; cw[j][1] = a[1]; cw[j][2] = a[2]; cw[j][3] = a[3]; cw[j][4] = b[0]; cw[j][5] = b[1]; cw[j][6] = b[2]; cw[j][7] = b[3]; }
      const f32x4 a = *(const f32x4*)(conv_b + ch0 + 8 * chn), b = *(const f32x4*)(conv_b + ch0 + 8 * chn + 4);
      cbv[0] = a[0]; cbv[1] = a[1]; cbv[2] = a[2]; cbv[3] = a[3]; cbv[4] = b[0]; cbv[5] = b[1]; cbv[6] = b[2]; cbv[7] = b[3]; }
    LDS_WAIT();
#pragma unroll 2
    for (int i = 0; i < 8; ++i) { const int t = 8 * i + rs;
        float xo[8];
#pragma unroll
        for (int e = 0; e < 8; ++e) xo[e] = cbv[e];
#pragma unroll
        for (int j = 0; j < 4; ++j) { const u32x4 uv = *(const LAS u32x4*)(wl + (t + j) * 128 + chn * 16);
            xo[0] += cw[j][0] * bflo(uv.x); xo[1] += cw[j][1] * bfhi(uv.x); xo[2] += cw[j][2] * bflo(uv.y); xo[3] += cw[j][3] * bfhi(uv.y);
            xo[4] += cw[j][4] * bflo(uv.z); xo[5] += cw[j][5] * bfhi(uv.z); xo[6] += cw[j][6] * bflo(uv.w); xo[7] += cw[j][7] * bfhi(uv.w); }
        u32x4 w; w.x = cvtpk(xo[0], xo[1]); w.y = cvtpk(xo[2], xo[3]); w.z = cvtpk(xo[4], xo[5]); w.w = cvtpk(xo[6], xo[7]);
        *(LAS u32x4*)(xcb + t * 128 + ((chn ^ ((t >> 1) & 7)) << 4)) = w; }
    LDS_WAIT();
    }
    {
        u32x4 gv[8];
#pragma unroll
        for (int i = 0; i < 8; ++i) gv[i] = *(const u32x4*)(GL + (size_t)(t0 + 8 * i + rs) * 1024 + ch0 + 8 * chn);
#pragma unroll
        for (int i = 0; i < 8; ++i) *(LAS u32x4*)(wl + (8 * i + rs) * 144 + chn * 16) = gv[i];
    }
    const int n = lane & 31, hh = lane >> 5;
#pragma unroll 1
    for (int jt = 0; jt < 2; ++jt) {
        const int chl = 32 * jt + n, ch = ch0 + chl;
        unsigned xb4[4];
#pragma unroll
        for (int q = 0; q < 4; ++q) { const int C = (q & 1) | ((q >> 1) << 2); xb4[q] = 9216u + hh * 512 + ((((chl >> 3) ^ (2 * hh)) ^ C) << 4) + (chl & 7) * 2; }
        bf16x8 bfr[2][4];
#pragma unroll
        for (int ks = 0; ks < 4; ++ks) { const size_t o = (size_t)nb * 4096 + (size_t)chl * 64 + 16 * ks + 8 * hh;
            bfr[0][ks] = *(const bf16x8*)(WRT + o); bfr[1][ks] = *(const bf16x8*)(WIT + o); }
        const float brv = b_r[ch], biv = b_i[ch], lsv = -8.0f * log1pf(expf(-lam[ch]));
        f32x16 av[2], bv[2];
        float s = 0.f, Atot = 1.f;
#pragma unroll
        for (int mt = 0; mt < 2; ++mt) {
            f32x16 ar, ai;
#pragma unroll
            for (int i = 0; i < 16; ++i) { ar[i] = 0.f; ai[i] = 0.f; }
            { const int row = 32 * mt + n;
#pragma unroll
              for (int ks = 0; ks < 4; ++ks) { const bf16x8 af = *(const LAS bf16x8*)(xcb + row * 128 + (((2 * ks + hh) ^ ((row >> 1) & 7)) << 4));
                  ar = MFMA32(af, bfr[0][ks], ar); ai = MFMA32(af, bfr[1][ks], ai); } }
#pragma unroll
            for (int rg = 0; rg < 16; ++rg) { const int tl = 32 * mt + (rg & 3) + 8 * (rg >> 2);
                const int q = (((rg >> 2) & 1) << 1) | ((rg & 3) >> 1);
                const float xc = bf2f(*(const LAS unsigned short*)(wl + xb4[q] + tl * 128));
                const float rr = fsigmoid(ar[rg] + brv); const float iv = fsigmoid(ai[rg] + biv);
                const float a_ = __expf(rr * lsv);
                const float b_ = __builtin_amdgcn_sqrtf(fmaxf(1.0f - a_ * a_, 0.f)) * iv * xc;
                ar[rg] = a_; ai[rg] = b_; }
            av[mt] = ar; bv[mt] = ai;
#pragma unroll
            for (int g = 0; g < 4; ++g) { float A = 1.f, B = 0.f;
#pragma unroll
                for (int e = 0; e < 4; ++e) { B = ar[4 * g + e] * B + ai[4 * g + e]; A = ar[4 * g + e] * A; }
                const float pA = __shfl_xor(A, 32), pB = __shfl_xor(B, 32);
                const float A0 = hh ? pA : A, B0 = hh ? pB : B, A1 = hh ? A : pA, B1 = hh ? B : pB;
                s = A1 * (A0 * s + B0) + B1; Atot = Atot * A0 * A1; }
        }
        if (hh == 0) { const unsigned long long gq = ((unsigned long long)__float_as_uint(s) << 32) | (unsigned long long)__float_as_uint(fmaxf(Atot, 1e-30f));
            __hip_atomic_store(TOT + (size_t)c * 1024 + ch, gq, __ATOMIC_RELAXED, __HIP_MEMORY_SCOPE_AGENT); }
        float fA = 1.f, fB = 0.f;
        {
            const int sc = c >> 4, rr_ = c & 15;
            const int cnt = hh ? rr_ : sc;
            unsigned long long* tp = hh ? (TOT + (size_t)(16 * sc) * 1024 + ch) : (TOT2 + ch);
            bool need_pub = (rr_ == 15);
            const float ownA = Atot, ownB = s;
            unsigned long long g[16];
            for (unsigned spins = 0;; ++spins) { bool ok = true;
#pragma unroll
                for (int k = 0; k < 16; ++k) { g[k] = 0x3f800000ull;
                    if (k < cnt) { g[k] = __hip_atomic_load(tp + (size_t)k * 1024, __ATOMIC_RELAXED, __HIP_MEMORY_SCOPE_AGENT); ok = ok && ((unsigned)g[k] != 0u); } }
                const unsigned long long okm = __builtin_amdgcn_ballot_w64(ok);
                if (need_pub && (unsigned)(okm >> 32) == 0xffffffffu) {
                    float tA = 1.f, tB = 0.f;
#pragma unroll
                    for (int k = 0; k < 16; ++k) { const float A = __uint_as_float((unsigned)g[k]), B = __uint_as_float((unsigned)(g[k] >> 32)); tB = A * tB + B; tA = A * tA; }
                    if (hh) { const unsigned long long gq = ((unsigned long long)__float_as_uint(ownA * tB + ownB) << 32) | (unsigned long long)__float_as_uint(fmaxf(ownA * tA, 1e-30f));
                        __hip_atomic_store(TOT2 + (size_t)sc * 1024 + ch, gq, __ATOMIC_RELAXED, __HIP_MEMORY_SCOPE_AGENT); }
                    need_pub = false;
                }
                if (okm == ~0ull || spins > (1u << 20)) break;
                __builtin_amdgcn_s_sleep(4);
            }
#pragma unroll
            for (int k = 0; k < 16; ++k) { const float A = __uint_as_float((unsigned)g[k]), B = __uint_as_float((unsigned)(g[k] >> 32)); fB = A * fB + B; fA = A * fA; }
        }
        s = __shfl(fA, 32 + n) * __shfl(fB, n) + __shfl(fB, 32 + n);
#pragma unroll
        for (int mt = 0; mt < 2; ++mt) {
            float sin_[4];
#pragma unroll
            for (int g = 0; g < 4; ++g) { float A = 1.f, B = 0.f;
#pragma unroll
                for (int e = 0; e < 4; ++e) { B = av[mt][4 * g + e] * B + bv[mt][4 * g + e]; A = av[mt][4 * g + e] * A; }
                const float pA = __shfl_xor(A, 32), pB = __shfl_xor(B, 32);
                const float A0 = hh ? pA : A, B0 = hh ? pB : B, A1 = hh ? A : pA, B1 = hh ? B : pB;
                const float mid = A0 * s + B0; sin_[g] = hh ? mid : s; s = A1 * mid + B1; }
            LAS unsigned char* gbase = wl + (4 * hh) * 144 + chl * 2;
#pragma unroll
            for (int g = 0; g < 4; ++g) { float hv = sin_[g];
#pragma unroll
                for (int e = 0; e < 4; ++e) { const int rg = 4 * g + e; hv = av[mt][rg] * hv + bv[mt][rg];
                    LAS unsigned short* gp = (LAS unsigned short*)(gbase + (32 * mt + e + 8 * g) * 144);
                    const float ov = hv * fsilu(bf2f(*gp));
                    *gp = (unsigned short)(cvtpk(ov, 0.f) & 0xffffu); } }
        }
    }
    LDS_WAIT();
#pragma unroll
    for (int i = 0; i < 8; ++i) { const u32x4 v = *(const LAS u32x4*)(wl + (8 * i + rs) * 144 + chn * 16);
        __builtin_amdgcn_raw_buffer_store_b128(v, __builtin_amdgcn_make_buffer_rsrc((void*)MX, (short)0, (int)((size_t)S * 2048 * 2), 0x00020000), (int)(((size_t)(t0 + 8 * i + rs) * 2048 + 1024 + ch0 + 8 * chn) * 2), 0, 16); }
    LDS_WAIT();
}

#define XB_TMO      128
#define XB_XCNT(j)  (256  + 64 * (j))
#define XB_XSUB(j)  (1280 + 64 * (j))
#define XB_XGEN(j)  (2304 + 64 * (j))
#define XB_TOP      3328
#define XB_TOPGEN   3392
#define XCD_BAR_WORDS 3456
#define XB_SPIN_CAP (1u << 18)
__device__ __forceinline__ unsigned xb_ld(unsigned* p)              { return __hip_atomic_load(p, __ATOMIC_RELAXED, __HIP_MEMORY_SCOPE_AGENT); }
__device__ __forceinline__ unsigned xb_add(unsigned* p, unsigned v) { return __hip_atomic_fetch_add(p, v, __ATOMIC_RELAXED, __HIP_MEMORY_SCOPE_AGENT); }
__device__ __forceinline__ unsigned xb_xcc_id() { return (unsigned)__builtin_amdgcn_s_getreg((3 << 11) | 20) & 0xFu; }
#define XB_SPIN(cond, bar) do { unsigned _sp = 0; while (cond) { __builtin_amdgcn_s_sleep(1); \
    if ((++_sp & 255u) == 0u) { if (xb_ld(&(bar)[XB_TMO])) break; if (_sp > XB_SPIN_CAP) { atomicAdd(&(bar)[XB_TMO], 1u); break; } } } } while (0)
struct XcdBarrier { unsigned* bar; unsigned x; volatile LAS unsigned* st; };
__device__ __forceinline__ XcdBarrier xcd_barrier_post(unsigned* bar, volatile LAS unsigned* st) {
    XcdBarrier b; b.bar = bar; b.x = xb_xcc_id(); b.st = st;
    if (threadIdx.x == 0) (void)xb_add(&bar[XB_XCNT(b.x)], 1u);
    return b;
}
__device__ __forceinline__ void xcd_barrier_complete(unsigned* bar, unsigned x, unsigned& nloc, unsigned& nx) {
    const unsigned G = gridDim.x * gridDim.y * gridDim.z;
    unsigned sum, cnt, mine, sp = 0u;
    for (;;) {
        sum = 0u; cnt = 0u; mine = 0u;
#pragma unroll
        for (unsigned j = 0; j < 16; ++j) { const unsigned c = xb_ld(&bar[XB_XCNT(j)]); sum += c; cnt += (c > 0u) ? 1u : 0u; mine = (j == x) ? c : mine; }
        if (sum == G) break;
        __builtin_amdgcn_s_sleep(1);
        if ((++sp & 255u) == 0u) { if (xb_ld(&bar[XB_TMO])) break; if (sp > XB_SPIN_CAP) { atomicAdd(&bar[XB_TMO], 1u); break; } }
    }
    nloc = mine > 0u ? mine : 1u; nx = cnt > 0u ? cnt : 1u;
}
__device__ __forceinline__ void xcd_barrier(const XcdBarrier& b) {
    asm volatile("s_waitcnt vmcnt(0)" ::: "memory");
    __syncthreads();
    if (threadIdx.x == 0) {
        unsigned* bar = b.bar;
        __builtin_amdgcn_s_waitcnt(0);
        unsigned nloc = b.st[0], nx = b.st[1];
        if (nloc == 0u) { xcd_barrier_complete(bar, b.x, nloc, nx); b.st[0] = nloc; b.st[1] = nx; }
        const unsigned old = xb_add(&bar[XB_XSUB(b.x)], 1u);
        const unsigned gen = old / nloc;
        if (old + 1u == (gen + 1u) * nloc) {
            __builtin_amdgcn_fence(__ATOMIC_RELEASE, "agent");
            asm volatile("s_waitcnt vmcnt(0)" ::: "memory");
            const unsigned og = xb_add(&bar[XB_TOP], 1u);
            const unsigned tg = og / nx;
            if (og + 1u == (tg + 1u) * nx) xb_add(&bar[XB_TOPGEN], 1u);
            else XB_SPIN(xb_ld(&bar[XB_TOPGEN]) == tg, bar);
            __builtin_amdgcn_fence(__ATOMIC_ACQUIRE, "agent");
            xb_add(&bar[XB_XGEN(b.x)], 1u);
            asm volatile("s_waitcnt vmcnt(0)" ::: "memory");
        } else {
            XB_SPIN(xb_ld(&bar[XB_XGEN(b.x)]) == gen, bar);
            __builtin_amdgcn_fence(__ATOMIC_ACQUIRE, "agent");
            asm volatile("s_waitcnt vmcnt(0)" ::: "memory");
        }
    }
    __syncthreads();
}

struct Args {
    const float *x, *c, *norm_gain, *w_ada, *b_ada, *w_in, *conv_w, *conv_b, *w_rgate, *b_rgate, *w_igate, *b_igate, *lru_lambda, *w_out, *final_gain;
    float* out; unsigned char* ws; int ph_lo, ph_hi, coop, pad;
};

__global__ void __launch_bounds__(NWAVES * 64, 2) hymba_fwd(Args a) {
    extern __shared__ __attribute__((aligned(16))) unsigned char lds_raw[];
    LAS unsigned char* lds = (LAS unsigned char*)lds_raw;
    const int tid = threadIdx.x, lane = tid & 63, wave = __builtin_amdgcn_readfirstlane(tid >> 6);
    const int G = gridDim.x; const int bx = blockIdx.x;
    const int vcu = (G % 8 == 0) ? (bx % 8) * (G / 8) + bx / 8 : bx;
    const int gw = vcu * NWAVES + wave, NGW = G * NWAVES;
    unsigned char* ws = a.ws;
    float* mod = (float*)(ws + WS_MOD);
    bf16_t* WRT = (bf16_t*)(ws + WS_WRT); bf16_t* WIT = (bf16_t*)(ws + WS_WIT);
    unsigned long long* TOT = (unsigned long long*)(ws + WS_TOT);
    bf16_t* WIN = (bf16_t*)(ws + WS_WIN); bf16_t* WOUT = (bf16_t*)(ws + WS_WOUT);
    bf16_t* HB = (bf16_t*)(ws + WS_H); bf16_t* MX = HB;
    bf16_t* PJ = (bf16_t*)(ws + WS_PROJ);
    bf16_t* OPB = (bf16_t*)(ws + WS_OP); float* LSEB = (float*)(ws + WS_LSE);
    const int lo = a.ph_lo, hi = a.ph_hi;
    volatile LAS unsigned* xst = (volatile LAS unsigned*)(lds + 143360);
    if (tid < 2) xst[tid] = 0u;
    __syncthreads();
    XcdBarrier xbar; xbar.bar = (unsigned*)ws; xbar.x = 0; xbar.st = xst;
    if (a.coop == 1) xbar = xcd_barrier_post((unsigned*)ws, xst);
#define IN(k) (lo <= (k) && (k) < hi)
#ifndef REP_A
#define REP_A 1
#endif
#ifndef REP_B
#define REP_B 1
#endif
#ifndef REP_S
#define REP_S 1
#endif
#ifndef REP_G
#define REP_G 1
#endif
#ifndef REP_H
#define REP_H 1
#endif
#define SEAM(k) do { if (a.coop && IN(k) && IN((k) + 1)) { for (int rs_ = 0; rs_ < REP_S; ++rs_) { xcd_barrier(xbar); } } } while (0)

    for (int rep_ = 0; rep_ < REP_A; ++rep_) if (IN(0)) {
        { unsigned long long* z = (unsigned long long*)(ws + WS_TOT); const size_t me = (size_t)bx * (NWAVES * 64) + tid, T = (size_t)G * (NWAVES * 64);
          for (size_t q = me; q < (size_t)128 * 1024; q += T) z[q] = 0ull;
          unsigned long long* z2 = (unsigned long long*)(ws + WS_TOT2);
          for (size_t q = me; q < (size_t)8 * 1024; q += T) z2[q] = 0ull; }
        for (int grp = bx; grp < PW / 32; grp += G) {
            const int sub = lane >> 3, ch = lane & 7;
            f32x4 acc = (f32x4){0.f, 0.f, 0.f, 0.f};
            const float* wp = a.w_ada + (size_t)(256 * wave + sub) * PW + 32 * grp + 4 * ch;
#pragma unroll 8
            for (int i = 0; i < 32; ++i) { const float cv = a.c[256 * wave + 8 * i + sub]; const float ca = cv * fsigmoid(cv);
                const f32x4 w4 = __builtin_nontemporal_load((const f32x4*)(wp + (size_t)(8 * i) * PW)); acc += ca * w4; }
#pragma unroll
            for (int e = 0; e < 4; ++e) { float v = acc[e]; v += __shfl_xor(v, 8); v += __shfl_xor(v, 16); v += __shfl_xor(v, 32); acc[e] = v; }
            LAS float* red = (LAS float*)lds;
            if (lane < 8) {
#pragma unroll
                for (int e = 0; e < 4; ++e) red[wave * 32 + 4 * lane + e] = acc[e]; }
            __syncthreads();
            if (tid < 32) { float s = a.b_ada[32 * grp + tid];
#pragma unroll
                for (int w = 0; w < 8; ++w) s += red[w * 32 + tid];
                mod[32 * grp + tid] = s; }
            __syncthreads();
        }
        LAS float* scr = (LAS float*)(lds + wave * 16384);
        constexpr int I_IN = (DM / 64) * (PW / 32), I_OUT = (DM / 64) * (DM / 32), I_G = 32;
        const int ngv = (PW / 32) < G ? (PW / 32) : G;
        const int NV = ngv * NWAVES + (G - ngv) * NWAVES * 2;
        const int nv = bx < ngv ? 1 : 2, vw0 = bx < ngv ? bx * NWAVES + wave : ngv * NWAVES + (bx - ngv) * NWAVES * 2 + wave * 2;
        for (int v = 0; v < nv; ++v)
        for (int it = vw0 + v; it < I_IN + I_OUT + 2 * I_G; it += NV) {
            int r = it;
            if (r < I_IN) { transpose_item(a.w_in, DM, PW, WIN, scr, r, lane); continue; } r -= I_IN;
            if (r < I_OUT) { transpose_item(a.w_out, DM, DM, WOUT, scr, r, lane); continue; } r -= I_OUT;
            if (r < I_G) { transpose_item(a.w_rgate + (size_t)(r >> 1) * 4096, 64, 64, WRT + (size_t)(r >> 1) * 4096, scr, r & 1, lane); continue; } r -= I_G;
            transpose_item(a.w_igate + (size_t)(r >> 1) * 4096, 64, 64, WIT + (size_t)(r >> 1) * 4096, scr, r & 1, lane);
        }
    }
    SEAM(0);
    for (int rep_ = 0; rep_ < REP_A; ++rep_) if (IN(1)) {
        f32x4 gs[8], sh[8];
#pragma unroll
        for (int j = 0; j < 8; ++j) { const int col = 4 * lane + 256 * j; const f32x4 g = *(const f32x4*)(a.norm_gain + col); const f32x4 sc = *(const f32x4*)(mod + DM + col);
            gs[j] = g * (sc + 1.0f); sh[j] = *(const f32x4*)(mod + col); }
        for (int row = gw; row < S; row += NGW) {
            const f32x4* xr = (const f32x4*)(a.x + (size_t)row * DM) + lane;
            f32x4 v[8]; float ss = 0.f;
#pragma unroll
            for (int j = 0; j < 8; ++j) { v[j] = __builtin_nontemporal_load(xr + 64 * j); ss += (v[j].x * v[j].x + v[j].y * v[j].y) + (v[j].z * v[j].z + v[j].w * v[j].w); }
            const float rstd = rsqrtf(wave_sum(ss) * (1.0f / DM) + EPS);
            u32x2* o8 = (u32x2*)(HB + (size_t)row * DM) + lane;
#pragma unroll
            for (int j = 0; j < 8; ++j) { const f32x4 hv = v[j] * rstd * gs[j] + sh[j]; u32x2 w; w.x = cvtpk(hv.x, hv.y); w.y = cvtpk(hv.z, hv.w); o8[64 * j] = w; }
        }
    }
    SEAM(1);
    for (int rep_ = 0; rep_ < REP_G; ++rep_) if (IN(2)) {
        pg8::Gemm g{HB, WIN, S, PW, DM}; pg8::StaticOrder So; So.init(S, PW, G, bx);
        pg8::EpiBf16 E{PJ, 1024, 1024, PROJ_STRIDE, QSCALE};
        pg8::gemm_phase<pg8::EpiBf16, pg8::StaticOrder, true, true>(lds, g, So, E);
    }
    SEAM(2);
    for (int rep_ = 0; rep_ < REP_B; ++rep_) if (IN(3)) {
        { LAS unsigned char* wl = lds + wave * LRU_WL;
          for (int u = gw; u < 128 * 16; u += NGW) lru_unit(wl, PJ + 4 * PROJ_STRIDE, PJ + 5 * PROJ_STRIDE, WRT, WIT, a.conv_w, a.conv_b, a.b_rgate, a.b_igate, a.lru_lambda, TOT, MX, u >> 4, u & 15, lane); }
        __syncthreads();
        attn_phase(lds, PJ, PJ + PROJ_STRIDE, PJ + 2 * PROJ_STRIDE, OPB, LSEB, (unsigned*)ws + 8192, wave, lane, tid);
    }
    SEAM(3);
    for (int rep_ = 0; rep_ < REP_B; ++rep_) if (IN(4)) {
        const bf16_t* GA = PJ + 3 * PROJ_STRIDE;
        for (int e = gw * 64 + lane; e < S * 128; e += NGW * 64) { const int t = e >> 7, c8 = e & 127, hd = c8 >> 3;
            const float l0 = LSEB[(size_t)t * 16 + hd], l1 = LSEB[(size_t)S * 16 + (size_t)t * 16 + hd], l2 = LSEB[(size_t)2 * S * 16 + (size_t)t * 16 + hd];
            const float mx = fmaxf(l0, fmaxf(l1, l2));
            float w0 = __builtin_amdgcn_exp2f(l0 - mx), w1 = __builtin_amdgcn_exp2f(l1 - mx), w2 = __builtin_amdgcn_exp2f(l2 - mx);
            const float wi = __builtin_amdgcn_rcpf(w0 + w1 + w2); w0 *= wi; w1 *= wi; w2 *= wi;
            const size_t off = (size_t)t * 1024 + 8 * c8;
            const u32x4 a0 = __builtin_nontemporal_load((const u32x4*)(OPB + off)), a1 = __builtin_nontemporal_load((const u32x4*)(OPB + PROJ_STRIDE + off)), a2 = __builtin_nontemporal_load((const u32x4*)(OPB + 2 * PROJ_STRIDE + off)), gg = __builtin_nontemporal_load((const u32x4*)(GA + off));
            u32x4 o;
#pragma unroll
            for (int k = 0; k < 4; ++k) { const float lo = (w0 * bflo(a0[k]) + w1 * bflo(a1[k]) + w2 * bflo(a2[k])) * fsilu(bflo(gg[k])); const float hi = (w0 * bfhi(a0[k]) + w1 * bfhi(a1[k]) + w2 * bfhi(a2[k])) * fsilu(bfhi(gg[k]));
                o[k] = cvtpk(lo, hi); }
            __builtin_amdgcn_raw_buffer_store_b128(o, __builtin_amdgcn_make_buffer_rsrc((void*)MX, (short)0, (int)((size_t)S * 2048 * 2), 0x00020000), (int)(((size_t)t * 2048 + 8 * c8) * 2), 0, 16); }
    }
    SEAM(4);
    const bool fused_final = (G == 256);
    if (IN(5)) {
        __syncthreads();
        pg8::Gemm g{MX, WOUT, S, DM, DM}; pg8::StaticOrder So; So.init(S, DM, G, bx);
        if (fused_final) {
            pg8::EpiFinal E{a.x, mod + 2 * DM, a.final_gain, a.out, DM, (float*)(ws + WS_SLOT), (unsigned*)ws + 4096};
            pg8::gemm_phase<pg8::EpiFinal, pg8::StaticOrder, false, true>(lds, g, So, E);
        } else {
            pg8::EpiResGate E{a.x, mod + 2 * DM, a.out, DM};
            pg8::gemm_phase<pg8::EpiResGate, pg8::StaticOrder, true, true>(lds, g, So, E);
        }
    }
    if (!fused_final) SEAM(5);
    if (IN(6) && !fused_final) {
        f32x4 fg[8];
#pragma unroll
        for (int j = 0; j < 8; ++j) fg[j] = *(const f32x4*)(a.final_gain + 4 * lane + 256 * j);
        for (int row = gw; row < S; row += NGW) {
            f32x4* yr = (f32x4*)(a.out + (size_t)row * DM) + lane;
            f32x4 v[8]; float ss = 0.f;
#pragma unroll
            for (int j = 0; j < 8; ++j) { v[j] = yr[64 * j]; ss += (v[j].x * v[j].x + v[j].y * v[j].y) + (v[j].z * v[j].z + v[j].w * v[j].w); }
            const float rstd = rsqrtf(wave_sum(ss) * (1.0f / DM) + EPS);
#pragma unroll
            for (int j = 0; j < 8; ++j) yr[64 * j] = v[j] * rstd * fg[j];
        }
    }
#undef IN
#undef SEAM
}

#ifndef MK_MULTI
#define MK_MULTI 0
#endif
extern "C" void kernel_launch(void* const* d_in, const int* in_sizes, int n_in, void* d_out, int out_size, void* d_ws, size_t ws_size, hipStream_t stream) {
    static int grid = 0;
    if (grid == 0) {
        int dev = 0, cus = 0, per_cu = 0;
        hipGetDevice(&dev);
        hipDeviceGetAttribute(&cus, hipDeviceAttributeMultiprocessorCount, dev);
        hipFuncSetAttribute((const void*)hymba_fwd, hipFuncAttributeMaxDynamicSharedMemorySize, LDS_BYTES);
        hipOccupancyMaxActiveBlocksPerMultiprocessor(&per_cu, (const void*)hymba_fwd, NWAVES * 64, LDS_BYTES);
        if (per_cu < 1) { fprintf(stderr, "kernel_launch: occupancy query returned %d\n", per_cu); per_cu = 1; }
        (void)hipGetLastError();
        grid = cus * per_cu;
    }
    (void)hipMemsetAsync(d_ws, 0, 40960, stream);
    Args a{};
    a.x = (const float*)d_in[0]; a.c = (const float*)d_in[1]; a.norm_gain = (const float*)d_in[2]; a.w_ada = (const float*)d_in[3]; a.b_ada = (const float*)d_in[4];
    a.w_in = (const float*)d_in[5]; a.conv_w = (const float*)d_in[6]; a.conv_b = (const float*)d_in[7]; a.w_rgate = (const float*)d_in[8]; a.b_rgate = (const float*)d_in[9];
    a.w_igate = (const float*)d_in[10]; a.b_igate = (const float*)d_in[11]; a.lru_lambda = (const float*)d_in[12]; a.w_out = (const float*)d_in[13]; a.final_gain = (const float*)d_in[14];
    a.out = (float*)d_out; a.ws = (unsigned char*)d_ws; a.pad = 0;
#if MK_MULTI
    for (int p = 0; p < NPH; ++p) { a.ph_lo = p; a.ph_hi = p + 1; a.coop = 0; hipLaunchKernelGGL(hymba_fwd, dim3(grid), dim3(NWAVES * 64), LDS_BYTES, stream, a); }
#else
    a.ph_lo = 0; a.ph_hi = NPH; a.coop = 1;
    void* args[] = {&a};
    hipError_t e = hipLaunchCooperativeKernel((const void*)hymba_fwd, dim3(grid), dim3(NWAVES * 64), args, LDS_BYTES, stream);
    if (e != hipSuccess) fprintf(stderr, "launch failed: %s (grid %d)\n", hipGetErrorString(e), grid);
#endif
}
```

```cpp
#include <hip/hip_runtime.h>
#include <hip/hip_cooperative_groups.h>
#include <cstdio>
#include <cstdint>
namespace cg = cooperative_groups;

#define LAS __attribute__((address_space(3)))
typedef unsigned short bf16_t;
typedef short bf16x8 __attribute__((ext_vector_type(8)));
typedef short s16x4 __attribute__((ext_vector_type(4)));
typedef float f32x4 __attribute__((ext_vector_type(4)));
typedef float f32x16 __attribute__((ext_vector_type(16)));
typedef unsigned u32x4 __attribute__((ext_vector_type(4)));
typedef unsigned u32x2 __attribute__((ext_vector_type(2)));
typedef float f32x2_t __attribute__((ext_vector_type(2)));
typedef __bf16 bf16x2_t __attribute__((ext_vector_type(2)));
typedef short v4i16_t __attribute__((ext_vector_type(4)));

constexpr int S = 8192, DM = 2048, PW = 6144, AW = 1024, NH = 16;
constexpr float EPS = 1e-6f;
constexpr float LOG2E = 1.4426950408889634f;
constexpr float QSCALE = 0.125f * LOG2E;
constexpr int NWAVES = 8;
constexpr int LDS_BYTES = 147456;
constexpr int NPH = 7;

constexpr size_t MiB = 1u << 20;
constexpr size_t WS_MOD = 1 * MiB;
constexpr size_t WS_WRT = 1 * MiB + 65536;
constexpr size_t WS_WIT = WS_WRT + 131072;
constexpr size_t WS_TOT2 = 1 * MiB + 512 * 1024;
constexpr size_t WS_TOT = 2 * MiB;
constexpr size_t WS_WIN = 4 * MiB;
constexpr size_t WS_WOUT = 28 * MiB;
constexpr size_t WS_H = 36 * MiB;
constexpr size_t WS_PROJ = 68 * MiB;
constexpr size_t PROJ_STRIDE = (size_t)S * 1024;
constexpr size_t WS_OP = 164 * MiB;
constexpr size_t WS_SLOT = 3 * MiB;
constexpr size_t WS_LSE = 212 * MiB;

__device__ __forceinline__ unsigned cvtpk(float lo, float hi) { f32x2_t v = {lo, hi}; bf16x2_t b = __builtin_convertvector(v, bf16x2_t); return __builtin_bit_cast(unsigned, b); }
__device__ __forceinline__ float bf2f(unsigned short u) { return __uint_as_float((unsigned)u << 16); }
__device__ __forceinline__ float bflo(unsigned u) { return __uint_as_float(u << 16); }
__device__ __forceinline__ float bfhi(unsigned u) { return __uint_as_float(u & 0xffff0000u); }
__device__ __forceinline__ float fsigmoid(float x) { return __builtin_amdgcn_rcpf(1.0f + __expf(-x)); }
__device__ __forceinline__ float fsilu(float x) { return x * fsigmoid(x); }
__device__ __forceinline__ float wave_sum(float v) {
#pragma unroll
    for (int o = 1; o < 64; o <<= 1) v += __shfl_xor(v, o);
    return v;
}

namespace pg8 {
#define PG8_LAS __attribute__((address_space(3)))
constexpr int BM = 256, BK = 64, HALF = 128, HTB = HALF * BK * 2, STAGE_BYTES = 8 * HTB, NXCD = 8, WGM = 8;
__host__ __device__ __forceinline__ int lds_byte(int r, int c) { const int st = (r >> 4) * 2 + (c >> 5), rr = r & 15, cc = c & 31, ob = rr * 64 + cc * 2; return st * 1024 + (ob ^ (((ob >> 9) & 1) << 5)); }
__host__ __device__ __forceinline__ void stage_rc(int b, int& R, int& C) { const int st = b / 1024, sb = b % 1024, swz = sb ^ (((sb >> 9) & 1) << 5); R = (st >> 1) * 16 + swz / 64; C = (st & 1) * 32 + (swz % 64) / 2; }
__host__ __device__ __forceinline__ int perm32(int rho) { const int n = rho >> 4, i = rho & 15; return 8 * (i >> 2) + 4 * n + (i & 3); }
struct Unit { int pm, pn; };
struct Gemm { const bf16_t* A; const bf16_t* Bt; int M, N, K; };
struct StaticOrder {
    int nM, nN, nwg, G, c;
    __host__ __device__ void init(int M, int N, int G_, int c_) { nM = M / BM; nN = N / BM; nwg = nM * nN; G = G_; c = c_; }
    __host__ __device__ bool next(int i, Unit& u) const {
        const long L = (long)i * G + c; if (L >= nwg) return false;
        int wgid = (int)L; { const int q = nwg / NXCD, r = nwg % NXCD, xcd = wgid % NXCD, off = wgid / NXCD; wgid = (xcd < r ? xcd * (q + 1) : r * (q + 1) + (xcd - r) * q) + off; }
        const int nig = WGM * nN, gid = wgid / nig, fm = gid * WGM, gsz = (nM - fm) < WGM ? (nM - fm) : WGM;
        u.pm = fm + ((wgid % nig) % gsz); u.pn = (wgid % nig) / gsz; return true;
    }
    __device__ __forceinline__ void a_ready(const Unit&) const {}
    __device__ __forceinline__ void done(const Unit&) const {}
};
__device__ __forceinline__ unsigned cvt_pk_bf16(float lo, float hi) { unsigned r; asm volatile("v_cvt_pk_bf16_f32 %0, %1, %2" : "=v"(r) : "v"(lo), "v"(hi)); return r; }

struct EpiBf16 {
    static constexpr bool PERM = true, AFTER_DRAIN = false;
    bf16_t* O; int ldc; int split_cols; size_t split_stride; float scale0;
    __device__ __forceinline__ void operator()(const f32x4 (&acc)[2][2][4][2], const Unit& u, int wr, int wc, int fr, int fq) const {
        const int row0 = u.pm * BM + wr * 64 + fr; int colt = u.pn * BM;
        float sc = 1.f; const int t = colt / split_cols; colt -= t * split_cols; if (t == 0) sc = scale0;
        const int col0 = colt + wc * 32 + 8 * fq;
        const __amdgpu_buffer_rsrc_t rs = __builtin_amdgcn_make_buffer_rsrc((void*)O, (short)0, (int)(6 * PROJ_STRIDE * 2), 0x00020000);
        const unsigned tb = (unsigned)((size_t)t * split_stride * 2);
#pragma unroll
        for (int ai = 0; ai < 2; ++ai)
#pragma unroll
            for (int m = 0; m < 4; ++m) { const unsigned ro = tb + (unsigned)(((row0 + ai * HALF + m * 16) * ldc + col0) * 2);
#pragma unroll
                for (int bj = 0; bj < 2; ++bj) { f32x4 v0 = acc[ai][bj][m][0] * sc, v1 = acc[ai][bj][m][1] * sc;
                    u32x4 w; w.x = cvt_pk_bf16(v0[0], v0[1]); w.y = cvt_pk_bf16(v0[2], v0[3]); w.z = cvt_pk_bf16(v1[0], v1[1]); w.w = cvt_pk_bf16(v1[2], v1[3]);
                    __builtin_amdgcn_raw_buffer_store_b128(w, rs, (int)(ro + bj * HALF * 2), 0, 16); } }
    }
    __device__ __forceinline__ void fused(f32x4 (&)[2][2][4][2], const Unit&, int, int, int, int, PG8_LAS unsigned char*, int, int) const {}
};
struct EpiResGate {
    static constexpr bool PERM = false, AFTER_DRAIN = false;
    const float* x; const float* gate; float* out; int ldc;
    __device__ __forceinline__ void operator()(const f32x4 (&acc)[2][2][4][2], const Unit& u, int wr, int wc, int fr, int fq) const {
        const int col0 = u.pn * BM + wc * 32 + 4 * fq;
        f32x4 gv[2][2];
#pragma unroll
        for (int bj = 0; bj < 2; ++bj)
#pragma unroll
            for (int n = 0; n < 2; ++n) gv[bj][n] = *(const f32x4*)(gate + col0 + bj * HALF + n * 16);
#pragma unroll
        for (int ai = 0; ai < 2; ++ai)
#pragma unroll
            for (int m = 0; m < 4; ++m) { const size_t off = (size_t)(u.pm * BM + ai * HALF + wr * 64 + m * 16 + fr) * ldc + col0;
#pragma unroll
                for (int bj = 0; bj < 2; ++bj)
#pragma unroll
                    for (int n = 0; n < 2; ++n) { const f32x4 xv = *(const f32x4*)(x + off + bj * HALF + n * 16);
                        *(f32x4*)(out + off + bj * HALF + n * 16) = xv + gv[bj][n] * acc[ai][bj][m][n]; } }
    }
    __device__ __forceinline__ void fused(f32x4 (&)[2][2][4][2], const Unit&, int, int, int, int, PG8_LAS unsigned char*, int, int) const {}
};

struct EpiFinal {
    static constexpr bool PERM = false, AFTER_DRAIN = true;
    const float* x; const float* gate; const float* fg; float* out; int ldc; float* slots; unsigned* cnt;
    __device__ __forceinline__ void operator()(const f32x4 (&)[2][2][4][2], const Unit&, int, int, int, int) const {}
    __device__ __forceinline__ void fused(f32x4 (&acc)[2][2][4][2], const Unit& u, int wr, int wc, int fr, int fq, PG8_LAS unsigned char* lds, int wid, int lane) const {
        const int col0 = u.pn * BM + wc * 32 + 4 * fq;
        PG8_LAS float* P = (PG8_LAS float*)lds;
        PG8_LAS float* Sr = (PG8_LAS float*)(lds + 4096);
        {
        f32x4 gv[2][2];
#pragma unroll
        for (int bj = 0; bj < 2; ++bj)
#pragma unroll
            for (int n = 0; n < 2; ++n) gv[bj][n] = *(const f32x4*)(gate + col0 + bj * HALF + n * 16);
#pragma unroll
        for (int ai = 0; ai < 2; ++ai)
#pragma unroll
            for (int m = 0; m < 4; ++m) { const int rl = ai * HALF + wr * 64 + m * 16 + fr; const size_t off = (size_t)(u.pm * BM + rl) * ldc + col0;
                float ss = 0.f;
#pragma unroll
                for (int bj = 0; bj < 2; ++bj)
#pragma unroll
                    for (int n = 0; n < 2; ++n) { const f32x4 xv = __builtin_nontemporal_load((const f32x4*)(x + off + bj * HALF + n * 16)); const f32x4 y = xv + gv[bj][n] * acc[ai][bj][m][n];
                        acc[ai][bj][m][n] = y; ss += (y[0] * y[0] + y[1] * y[1]) + (y[2] * y[2] + y[3] * y[3]); }
                ss += __shfl_xor(ss, 16); ss += __shfl_xor(ss, 32);
                if (fq == 0) P[rl * 4 + wc] = ss; }
        }
        asm volatile("s_waitcnt lgkmcnt(0)" ::: "memory"); __builtin_amdgcn_s_barrier(); asm volatile("" ::: "memory");
        const int row = wid * 32 + (lane & 31);
        if (lane < 32) { const float t = (P[row * 4 + 0] + P[row * 4 + 1]) + (P[row * 4 + 2] + P[row * 4 + 3]);
            __hip_atomic_store(slots + (size_t)(u.pm * BM + row) * 8 + u.pn, t, __ATOMIC_RELAXED, __HIP_MEMORY_SCOPE_AGENT); }
        asm volatile("s_waitcnt vmcnt(0)" ::: "memory");
        if (lane == 0) __hip_atomic_fetch_add(cnt + 64 * u.pm, 1u, __ATOMIC_RELAXED, __HIP_MEMORY_SCOPE_AGENT);
        if (wid == 0) {
            for (unsigned spins = 0; spins < (1u << 22); ++spins) {
                if ((unsigned)__builtin_amdgcn_readfirstlane(__hip_atomic_load(cnt + 64 * u.pm, __ATOMIC_RELAXED, __HIP_MEMORY_SCOPE_AGENT)) >= 64u) break;
                __builtin_amdgcn_s_sleep(2);
            }
            __builtin_amdgcn_fence(__ATOMIC_ACQUIRE, "agent");
        }
        asm volatile("s_waitcnt vmcnt(0) lgkmcnt(0)" ::: "memory"); __builtin_amdgcn_s_barrier(); asm volatile("" ::: "memory");
        if (lane < 32) { const float* sl = slots + (size_t)(u.pm * BM + row) * 8; float t = 0.f;
#pragma unroll
            for (int k = 0; k < 8; ++k) t += __hip_atomic_load(sl + k, __ATOMIC_RELAXED, __HIP_MEMORY_SCOPE_AGENT);
            Sr[row] = rsqrtf(t * (1.0f / 2048.0f) + 1e-6f); }
        asm volatile("s_waitcnt vmcnt(0) lgkmcnt(0)" ::: "memory"); __builtin_amdgcn_s_barrier(); asm volatile("" ::: "memory");
        f32x4 fv[2][2];
#pragma unroll
        for (int bj = 0; bj < 2; ++bj)
#pragma unroll
            for (int n = 0; n < 2; ++n) fv[bj][n] = *(const f32x4*)(fg + col0 + bj * HALF + n * 16);
#pragma unroll
        for (int ai = 0; ai < 2; ++ai)
#pragma unroll
            for (int m = 0; m < 4; ++m) { const int rl = ai * HALF + wr * 64 + m * 16 + fr; const size_t off = (size_t)(u.pm * BM + rl) * ldc + col0; const float rstd = Sr[rl];
#pragma unroll
                for (int bj = 0; bj < 2; ++bj)
#pragma unroll
                    for (int n = 0; n < 2; ++n) __builtin_nontemporal_store(acc[ai][bj][m][n] * rstd * fv[bj][n], (f32x4*)(out + off + bj * HALF + n * 16)); }
    }
};

template <class Epi, class Sched, bool ALIGN_EPI = false, bool SP2 = false>
__device__ __forceinline__ void gemm_phase(PG8_LAS unsigned char* lds, const Gemm g, const Sched& S, const Epi& E) {
    const int tid = threadIdx.x, wid = __builtin_amdgcn_readfirstlane(tid >> 6), lane = tid & 63, wr = wid >> 2, wc = wid & 3, fr = lane & 15, fq = lane >> 4;
    const int K = g.K, nt = K / BK;
    unsigned voffA[2], voffB[2];
#pragma unroll
    for (int i = 0; i < 2; ++i) { int R, C; stage_rc(tid * 16 + i * 8192, R, C); const int Rb = Epi::PERM ? ((R & ~31) + perm32(R & 31)) : R;
        voffA[i] = (unsigned)(R * K + C) * 2u; voffB[i] = (unsigned)(Rb * K + C) * 2u; }
    const size_t kstep = (size_t)(BK * 2);
    const size_t hstep = (size_t)HALF * K * 2;
    const size_t tstep = 2 * hstep;
    const unsigned ldsw = (unsigned)wid * 1024u;
    const int aoff = lds_byte(wr * 64 + fr, fq * 8), boff = lds_byte(wc * 32 + fr, fq * 8);
#define PG8_SA(b, h) (((b) * 2 + (h)) * HTB)
#define PG8_SB(b, h) ((4 + (b) * 2 + (h)) * HTB)
#define PG8_STAGE(bufoff, gbase, voff) do { _Pragma("unroll") for (int _i = 0; _i < 2; ++_i) \
        __builtin_amdgcn_global_load_lds((const unsigned*)((const char*)(gbase) + (voff)[_i]), (PG8_LAS unsigned*)(lds + (bufoff) + ldsw + _i * 8192), 16, 0, 0); } while (0)
#define PG8_LDA(dst, b, h) do { _Pragma("unroll") for (int m = 0; m < 4; ++m) _Pragma("unroll") for (int k = 0; k < 2; ++k) dst[m][k] = *(const PG8_LAS bf16x8*)(lds + PG8_SA(b, h) + aoff + m * 2048 + k * 1024); } while (0)
#define PG8_LDB(dst, b, h) do { _Pragma("unroll") for (int n = 0; n < 2; ++n) _Pragma("unroll") for (int k = 0; k < 2; ++k) dst[n][k] = *(const PG8_LAS bf16x8*)(lds + PG8_SB(b, h) + boff + n * 2048 + k * 1024); } while (0)
#define PG8_MMA(ai, bj, At, Bt) do { __builtin_amdgcn_s_setprio(1); _Pragma("unroll") for (int m = 0; m < 4; ++m) _Pragma("unroll") for (int n = 0; n < 2; ++n) _Pragma("unroll") for (int k = 0; k < 2; ++k) \
        acc[ai][bj][m][n] = __builtin_amdgcn_mfma_f32_16x16x32_bf16(Bt[n][k], At[m][k], acc[ai][bj][m][n], 0, 0, 0); __builtin_amdgcn_s_setprio(0); } while (0)
#define PG8_WAIT_V(n) asm volatile("s_waitcnt vmcnt(" #n ")" ::: "memory")
#define PG8_WAIT_L(n) asm volatile("s_waitcnt lgkmcnt(" #n ")" ::: "memory")
#define PG8_BAR __builtin_amdgcn_s_barrier()
#define PG8_SCHED __builtin_amdgcn_sched_barrier(0)
    Unit cur, nxt; int ui = 0;
    if (!S.next(0, cur)) return;
    f32x4 acc[2][2][4][2];
#pragma unroll
    for (int a = 0; a < 2; ++a)
#pragma unroll
        for (int b = 0; b < 2; ++b)
#pragma unroll
            for (int m = 0; m < 4; ++m)
#pragma unroll
                for (int n = 0; n < 2; ++n) acc[a][b][m][n] = (f32x4){0.f, 0.f, 0.f, 0.f};
    bf16x8 At[4][2], B0[2][2], B1[2][2];
    const char* cA = (const char*)g.A + (size_t)cur.pm * tstep; const char* cB = (const char*)g.Bt + (size_t)cur.pn * tstep;
    S.a_ready(cur);
    if constexpr (SP2) {
        PG8_STAGE(PG8_SB(0, 0), cB, voffB); PG8_STAGE(PG8_SB(0, 1), cB + hstep, voffB); PG8_STAGE(PG8_SA(0, 0), cA, voffA); PG8_STAGE(PG8_SA(0, 1), cA + hstep, voffA);
        if (wr == 1) PG8_BAR;
        PG8_WAIT_V(2); PG8_BAR;
        PG8_STAGE(PG8_SB(1, 0), cB + kstep, voffB); PG8_STAGE(PG8_SA(1, 0), cA + kstep, voffA); PG8_STAGE(PG8_SB(1, 1), cB + hstep + kstep, voffB);
        PG8_WAIT_V(6); PG8_BAR;
    } else {
        PG8_STAGE(PG8_SB(0, 0), cB, voffB); PG8_STAGE(PG8_SA(0, 0), cA, voffA); PG8_STAGE(PG8_SB(0, 1), cB + hstep, voffB); PG8_STAGE(PG8_SA(0, 1), cA + hstep, voffA);
        if (wr == 1) PG8_BAR;
        PG8_WAIT_V(4); PG8_BAR;
        PG8_STAGE(PG8_SB(1, 0), cB + kstep, voffB); PG8_STAGE(PG8_SA(1, 0), cA + kstep, voffA); PG8_STAGE(PG8_SB(1, 1), cB + hstep + kstep, voffB);
        PG8_WAIT_V(6); PG8_BAR;
    }
    for (;;) {
        const bool has_next = S.next(ui + 1, nxt);
        const char* nA = has_next ? (const char*)g.A + (size_t)nxt.pm * tstep : cA; const char* nB = has_next ? (const char*)g.Bt + (size_t)nxt.pn * tstep : cB;
        for (int t = 0; t < nt; t += 2) {
            const bool last = (t == nt - 2);
            const char* a1 = cA + (size_t)(t + 1) * kstep;
            const char* a2 = last ? nA : cA + (size_t)(t + 2) * kstep; const char* b2 = last ? nB : cB + (size_t)(t + 2) * kstep;
            const char* a3 = a2 + kstep; const char* b3 = b2 + kstep;
            if (last && has_next) S.a_ready(nxt);
            if constexpr (SP2) {
            PG8_LDB(B0, 0, 0); PG8_LDB(B1, 0, 1); PG8_SCHED; PG8_LDA(At, 0, 0); PG8_STAGE(PG8_SA(1, 1), a1 + hstep, voffA);
            PG8_WAIT_V(8); PG8_WAIT_L(0); PG8_BAR; PG8_MMA(0, 0, At, B0); PG8_MMA(0, 1, At, B1); PG8_BAR; PG8_SCHED;
            PG8_LDA(At, 0, 1); PG8_STAGE(PG8_SB(0, 0), b2, voffB); PG8_STAGE(PG8_SB(0, 1), b2 + hstep, voffB); PG8_STAGE(PG8_SA(0, 0), a2, voffA);
            PG8_WAIT_V(8); PG8_WAIT_L(0); PG8_BAR; PG8_MMA(1, 0, At, B0); PG8_MMA(1, 1, At, B1); PG8_BAR; PG8_SCHED;
            PG8_LDB(B0, 1, 0); PG8_LDB(B1, 1, 1); PG8_SCHED; PG8_LDA(At, 1, 0); PG8_STAGE(PG8_SA(0, 1), a2 + hstep, voffA);
            PG8_WAIT_V(8); PG8_WAIT_L(0); PG8_BAR; PG8_MMA(0, 0, At, B0); PG8_MMA(0, 1, At, B1); PG8_BAR; PG8_SCHED;
            PG8_LDA(At, 1, 1); PG8_STAGE(PG8_SB(1, 0), b3, voffB); PG8_STAGE(PG8_SB(1, 1), b3 + hstep, voffB); PG8_STAGE(PG8_SA(1, 0), a3, voffA);
            PG8_WAIT_V(8); PG8_WAIT_L(0); PG8_BAR; PG8_MMA(1, 0, At, B0); PG8_MMA(1, 1, At, B1); PG8_BAR; PG8_SCHED;
            } else {
            PG8_LDB(B0, 0, 0); PG8_SCHED; PG8_LDA(At, 0, 0); PG8_STAGE(PG8_SA(1, 1), a1 + hstep, voffA);
            PG8_WAIT_L(8); PG8_BAR; PG8_WAIT_L(0); PG8_MMA(0, 0, At, B0); PG8_BAR; PG8_SCHED;
            PG8_LDB(B1, 0, 1); PG8_STAGE(PG8_SB(0, 0), b2, voffB);
            PG8_BAR; PG8_WAIT_L(0); PG8_MMA(0, 1, At, B1); PG8_BAR;
            PG8_LDA(At, 0, 1); PG8_STAGE(PG8_SA(0, 0), a2, voffA);
            PG8_BAR; PG8_WAIT_L(0); PG8_MMA(1, 0, At, B0); PG8_BAR; PG8_SCHED;
            PG8_STAGE(PG8_SB(0, 1), b2 + hstep, voffB);
            PG8_WAIT_V(6); PG8_BAR; PG8_MMA(1, 1, At, B1); PG8_BAR;
            PG8_LDB(B0, 1, 0); PG8_SCHED; PG8_LDA(At, 1, 0); PG8_STAGE(PG8_SA(0, 1), a2 + hstep, voffA);
            PG8_WAIT_L(8); PG8_BAR; PG8_WAIT_L(0); PG8_MMA(0, 0, At, B0); PG8_BAR; PG8_SCHED;
            PG8_LDB(B1, 1, 1); PG8_STAGE(PG8_SB(1, 0), b3, voffB);
            PG8_BAR; PG8_WAIT_L(0); PG8_MMA(0, 1, At, B1); PG8_BAR;
            PG8_LDA(At, 1, 1); PG8_STAGE(PG8_SA(1, 0), a3, voffA);
            PG8_BAR; PG8_WAIT_L(0); PG8_MMA(1, 0, At, B0); PG8_BAR; PG8_SCHED;
            PG8_STAGE(PG8_SB(1, 1), b3 + hstep, voffB);
            PG8_WAIT_V(6); PG8_BAR; PG8_MMA(1, 1, At, B1); PG8_BAR;
            }
        }
        if constexpr (ALIGN_EPI) { if (wr == 0) PG8_BAR; }
        if constexpr (!Epi::AFTER_DRAIN) { E(acc, cur, wr, wc, fr, fq); S.done(cur); }
        if (!has_next) break;
#pragma unroll
        for (int a = 0; a < 2; ++a)
#pragma unroll
            for (int b = 0; b < 2; ++b)
#pragma unroll
                for (int m = 0; m < 4; ++m)
#pragma unroll
                    for (int n = 0; n < 2; ++n) acc[a][b][m][n] = (f32x4){0.f, 0.f, 0.f, 0.f};
        cur = nxt; cA = nA; cB = nB; ++ui;
        if constexpr (ALIGN_EPI) { if (wr == 1) PG8_BAR; }
    }
    PG8_WAIT_V(0);
    if constexpr (!ALIGN_EPI) { if (wr == 0) PG8_BAR; }
    PG8_BAR;
    if constexpr (Epi::AFTER_DRAIN) { E.fused(acc, cur, wr, wc, fr, fq, lds, wid, lane); S.done(cur); }
#undef PG8_SA
#undef PG8_SB
#undef PG8_STAGE
#undef PG8_LDA
#undef PG8_LDB
#undef PG8_MMA
#undef PG8_WAIT_V
#undef PG8_WAIT_L
#undef PG8_BAR
#undef PG8_SCHED
}
}

#define LDS_WAIT() asm volatile("s_waitcnt lgkmcnt(0)" ::: "memory")
#define MFMA32(a, b, c) __builtin_amdgcn_mfma_f32_32x32x16_bf16((a), (b), (c), 0, 0, 0)

__device__ __forceinline__ void transpose_item(const float* W, int K, int N, bf16_t* WT, LAS float* scr, int item, int lane) {
    const int nblk = N / 32, kb = item / nblk, nb = item % nblk, k0 = 64 * kb, n0 = 32 * nb;
    { const int kr = lane >> 3, c4 = lane & 7; f32x4 v[8];
#pragma unroll
      for (int i = 0; i < 8; ++i) v[i] = __builtin_nontemporal_load((const f32x4*)(W + (size_t)(k0 + 8 * i + kr) * N + n0 + 4 * c4));
#pragma unroll
      for (int i = 0; i < 8; ++i) { LAS float* d = scr + (8 * i + kr) * 33 + 4 * c4; d[0] = v[i][0]; d[1] = v[i][1]; d[2] = v[i][2]; d[3] = v[i][3]; } }
    LDS_WAIT();
    const int c = lane & 7;
    const __amdgpu_buffer_rsrc_t wt_rs = __builtin_amdgcn_make_buffer_rsrc((void*)WT, (short)0, K * N * 2, 0x00020000);
#pragma unroll
    for (int j = 0; j < 4; ++j) { const int n = (lane >> 3) + 8 * j; const LAS float* s = scr + (8 * c) * 33 + n;
        u32x4 o; o.x = cvtpk(s[0 * 33], s[1 * 33]); o.y = cvtpk(s[2 * 33], s[3 * 33]); o.z = cvtpk(s[4 * 33], s[5 * 33]); o.w = cvtpk(s[6 * 33], s[7 * 33]);
        __builtin_amdgcn_raw_buffer_store_b128(o, wt_rs, (int)(((size_t)(n0 + n) * K + k0 + 8 * c) * 2), 0, 16); }
    LDS_WAIT();
}

__device__ __forceinline__ void attn_phase(LAS unsigned char* lds, const bf16_t* __restrict__ Q, const bf16_t* __restrict__ Kb, const bf16_t* __restrict__ Vb,
                                           bf16_t* __restrict__ OPB, float* __restrict__ LSEB, unsigned* qctr, int wave, int lane, int tid) {
    const int n = lane & 31, hh = lane >> 5;
    const int prow = tid >> 3, pch = tid & 7;
    unsigned pkw[6];
#pragma unroll
    for (int i = 0; i < 6; ++i) { const int r384 = prow + 64 * i, j = r384 >> 5, row = r384 & 31; pkw[i] = j * 8192 + row * 128; }
    const unsigned kswz = (unsigned)((pch ^ ((prow >> 1) & 7)) << 4), vswz = 4096u + (unsigned)((pch ^ (((prow >> 1) & 1) << 2)) << 4);
    unsigned kr[4], vb[2];
#pragma unroll
    for (int ks = 0; ks < 4; ++ks) kr[ks] = n * 128 + (((2 * ks + hh) ^ ((n >> 1) & 7)) << 4);
    { const int gl = (lane >> 4) & 1, i16 = lane & 15, q = i16 >> 2, p = i16 & 3; const int row0 = 4 * hh + q, cb = 2 * gl + (p >> 1), sw = ((q >> 1) & 1) << 2;
#pragma unroll
      for (int dt = 0; dt < 2; ++dt) vb[dt] = 4096 + row0 * 128 + (((cb + 4 * dt) ^ sw) << 4) + 8 * (p & 1); }
    const bf16x8 ones = (bf16x8){0x3F80, 0x3F80, 0x3F80, 0x3F80, 0x3F80, 0x3F80, 0x3F80, 0x3F80};
    u32x4 pk[6], pv[6]; bf16x8 pq[4];
#define ATT_DECODE(bu_) const int p_ = (bu_) >> 9, rem_ = (bu_) & 511, h_ = rem_ >> 5, i8_ = rem_ & 31; const int dsh_ = p_ == 0 ? 4 : (p_ == 1 ? 2 : 0), gsh_ = 8 - dsh_; \
        const int rho_ = (i8_ * 8) >> gsh_, grp0_ = (i8_ * 8) & ((1 << gsh_) - 1);
#define ATT_FETCH(bu_) do { ATT_DECODE(bu_) \
        _Pragma("unroll") for (int i = 0; i < 6; ++i) { const int kp = 32 * (grp0_ - 4) + prow + 64 * i; pk[i] = (u32x4){0u, 0u, 0u, 0u}; pv[i] = pk[i]; \
            if (kp >= 0) { const size_t o_ = ((size_t)rho_ + ((size_t)kp << dsh_)) * 1024 + h_ * 64 + 8 * pch; pk[i] = *(const u32x4*)(Kb + o_); pv[i] = *(const u32x4*)(Vb + o_); } } \
        { const int tq_ = rho_ + ((32 * (grp0_ + wave) + n) << dsh_); const bf16_t* qp_ = Q + (size_t)tq_ * 1024 + h_ * 64 + 8 * hh; \
          _Pragma("unroll") for (int ks = 0; ks < 4; ++ks) pq[ks] = *(const bf16x8*)(qp_ + 16 * ks); } } while (0)
    volatile LAS int* slot = (volatile LAS int*)(lds + 98304);
    if (tid == 0) slot[0] = (int)__hip_atomic_fetch_add(qctr, 1u, __ATOMIC_RELAXED, __HIP_MEMORY_SCOPE_AGENT);
    asm volatile("s_waitcnt vmcnt(0) lgkmcnt(0)" ::: "memory"); __builtin_amdgcn_s_barrier(); asm volatile("" ::: "memory");
    int bu = slot[0];
    if (bu < 1536) ATT_FETCH(bu);
    while (bu < 1536) {
        ATT_DECODE(bu)
        asm volatile("s_waitcnt lgkmcnt(0)" ::: "memory"); __builtin_amdgcn_s_barrier();
#pragma unroll
        for (int i = 0; i < 6; ++i) { *(LAS u32x4*)(lds + pkw[i] + kswz) = pk[i]; *(LAS u32x4*)(lds + pkw[i] + vswz) = pv[i]; }
        bf16x8 qf[4];
#pragma unroll
        for (int ks = 0; ks < 4; ++ks) qf[ks] = pq[ks];
        if (tid == 0) { slot[0] = (int)__hip_atomic_fetch_add(qctr, 1u, __ATOMIC_RELAXED, __HIP_MEMORY_SCOPE_AGENT); asm volatile("s_waitcnt vmcnt(0)" ::: "memory"); }
        asm volatile("s_waitcnt lgkmcnt(0)" ::: "memory"); __builtin_amdgcn_s_barrier(); asm volatile("" ::: "memory");
        const int nbu = slot[0];
        if (nbu < 1536) ATT_FETCH(nbu);
        const int grp = grp0_ + wave;
        const int tq = rho_ + ((32 * grp + n) << dsh_);
        const float sd = __builtin_amdgcn_exp2f(-0.5f * (float)(h_ + 1)) * LOG2E * (float)(1 << dsh_);
        const float sd32 = 32.0f * sd;
        f32x16 o0, o1, lacc, aci;
#pragma unroll
        for (int i = 0; i < 16; ++i) { o0[i] = 0.f; o1[i] = 0.f; lacc[i] = 0.f; aci[i] = sd * (float)((i & 3) + 8 * (i >> 2) + 4 * hh); }
        float m = -1e30f;
        const int ktmin = grp >= 4 ? 0 : 4 - grp;
        LAS unsigned char* wt = lds + wave * 8192;
#define ATT_TR(addr) __builtin_amdgcn_ds_read_tr16_b64_v4i16((LAS v4i16_t*)(addr))
#define ATT_PV2(tb, pf0, pf1) do { \
        const v4i16_t l00 = ATT_TR((tb) + vb[0]), h00 = ATT_TR((tb) + vb[0] + 1024), l01 = ATT_TR((tb) + vb[1]), h01 = ATT_TR((tb) + vb[1] + 1024); \
        const v4i16_t l10 = ATT_TR((tb) + 2048 + vb[0]), h10 = ATT_TR((tb) + 2048 + vb[0] + 1024), l11 = ATT_TR((tb) + 2048 + vb[1]), h11 = ATT_TR((tb) + 2048 + vb[1] + 1024); \
        o0 = MFMA32(__builtin_shufflevector(l00, h00, 0, 1, 2, 3, 4, 5, 6, 7), pf0, o0); o1 = MFMA32(__builtin_shufflevector(l01, h01, 0, 1, 2, 3, 4, 5, 6, 7), pf0, o1); lacc = MFMA32(ones, pf0, lacc); \
        o0 = MFMA32(__builtin_shufflevector(l10, h10, 0, 1, 2, 3, 4, 5, 6, 7), pf1, o0); o1 = MFMA32(__builtin_shufflevector(l11, h11, 0, 1, 2, 3, 4, 5, 6, 7), pf1, o1); lacc = MFMA32(ones, pf1, lacc); } while (0)
        for (int kt = 4; kt >= ktmin; kt -= 2) {
            const bool hasB = (kt - 1 >= ktmin);
            LAS unsigned char* tA = wt + kt * 8192; LAS unsigned char* tB = tA - 8192;
            f32x16 x0 = aci, x1 = aci;
#pragma unroll
            for (int ks = 0; ks < 4; ++ks) { const bf16x8 kf = *(const LAS bf16x8*)(tA + kr[ks]); x0 = MFMA32(kf, qf[ks], x0); }
            if (hasB) {
#pragma unroll
                for (int ks = 0; ks < 4; ++ks) { const bf16x8 kf = *(const LAS bf16x8*)(tB + kr[ks]); x1 = MFMA32(kf, qf[ks], x1); }
            } else {
#pragma unroll
                for (int rg = 0; rg < 16; ++rg) x1[rg] = -INFINITY;
            }
            if (kt == 4) {
#pragma unroll
                for (int rg = 0; rg < 16; ++rg) { const int cr = (rg & 3) + 8 * (rg >> 2) + 4 * hh; x0[rg] = (cr <= n) ? x0[rg] : -INFINITY; }
            } else if (kt == 0) {
#pragma unroll
                for (int rg = 0; rg < 16; ++rg) { const int cr = (rg & 3) + 8 * (rg >> 2) + 4 * hh; x0[rg] = (cr >= n) ? x0[rg] : -INFINITY; }
            }
            float tmax = fmaxf(fmaxf(x0[0], x0[1]), fmaxf(x0[2], x0[3])), tmb = fmaxf(fmaxf(x1[0], x1[1]), fmaxf(x1[2], x1[3]));
#pragma unroll
            for (int rg = 4; rg < 16; rg += 4) { tmax = fmaxf(tmax, fmaxf(fmaxf(x0[rg], x0[rg + 1]), fmaxf(x0[rg + 2], x0[rg + 3]))); tmb = fmaxf(tmb, fmaxf(fmaxf(x1[rg], x1[rg + 1]), fmaxf(x1[rg + 2], x1[rg + 3]))); }
            tmax = fmaxf(tmax, tmb - sd32);
            { auto rr = __builtin_amdgcn_permlane32_swap(__float_as_uint(tmax), __float_as_uint(tmax), false, false);
              tmax = fmaxf(__uint_as_float(rr[0]), __uint_as_float(rr[1])); }
            const float c0 = sd32 * (float)kt;
            const float mn = fmaxf(m, tmax + c0);
            if (__builtin_amdgcn_ballot_w64(mn > m) != 0ull) {
                const float alpha = __builtin_amdgcn_exp2f(m - mn);
#pragma unroll
                for (int i = 0; i < 16; ++i) { o0[i] *= alpha; o1[i] *= alpha; lacc[i] *= alpha; }
                m = mn;
            }
            const float mm = m - c0, mmB = mm + sd32;
            bf16x8 pA[2], pB[2];
#pragma unroll
            for (int s2 = 0; s2 < 2; ++s2) { u32x4 pw;
                pw.x = cvtpk(__builtin_amdgcn_exp2f(x0[8 * s2] - mm), __builtin_amdgcn_exp2f(x0[8 * s2 + 1] - mm)); pw.y = cvtpk(__builtin_amdgcn_exp2f(x0[8 * s2 + 2] - mm), __builtin_amdgcn_exp2f(x0[8 * s2 + 3] - mm));
                pw.z = cvtpk(__builtin_amdgcn_exp2f(x0[8 * s2 + 4] - mm), __builtin_amdgcn_exp2f(x0[8 * s2 + 5] - mm)); pw.w = cvtpk(__builtin_amdgcn_exp2f(x0[8 * s2 + 6] - mm), __builtin_amdgcn_exp2f(x0[8 * s2 + 7] - mm));
                pA[s2] = __builtin_bit_cast(bf16x8, pw); }
            ATT_PV2(tA, pA[0], pA[1]);
            if (hasB) {
#pragma unroll
                for (int s2 = 0; s2 < 2; ++s2) { u32x4 pw;
                    pw.x = cvtpk(__builtin_amdgcn_exp2f(x1[8 * s2] - mmB), __builtin_amdgcn_exp2f(x1[8 * s2 + 1] - mmB)); pw.y = cvtpk(__builtin_amdgcn_exp2f(x1[8 * s2 + 2] - mmB), __builtin_amdgcn_exp2f(x1[8 * s2 + 3] - mmB));
                    pw.z = cvtpk(__builtin_amdgcn_exp2f(x1[8 * s2 + 4] - mmB), __builtin_amdgcn_exp2f(x1[8 * s2 + 5] - mmB)); pw.w = cvtpk(__builtin_amdgcn_exp2f(x1[8 * s2 + 6] - mmB), __builtin_amdgcn_exp2f(x1[8 * s2 + 7] - mmB));
                    pB[s2] = __builtin_bit_cast(bf16x8, pw); }
                ATT_PV2(tB, pB[0], pB[1]);
            }
        }
#undef ATT_PV2
#undef ATT_TR
        const float lt = lacc[0];
        const float inv = __builtin_amdgcn_rcpf(lt);
        bf16_t* OP = OPB + (size_t)p_ * PROJ_STRIDE; float* LSE = LSEB + (size_t)p_ * S * 16;
        if (hh == 0) LSE[(size_t)tq * 16 + h_] = m + __builtin_amdgcn_logf(lt) - sd * (float)(n + 128);
        u32x2 pk8[8];
#pragma unroll
        for (int dt = 0; dt < 2; ++dt)
#pragma unroll
            for (int g = 0; g < 4; ++g) {
                float v0, v1, v2, v3;
                if (dt == 0) { v0 = o0[4 * g]; v1 = o0[4 * g + 1]; v2 = o0[4 * g + 2]; v3 = o0[4 * g + 3]; } else { v0 = o1[4 * g]; v1 = o1[4 * g + 1]; v2 = o1[4 * g + 2]; v3 = o1[4 * g + 3]; }
                pk8[4 * dt + g].x = cvtpk(v0 * inv, v1 * inv); pk8[4 * dt + g].y = cvtpk(v2 * inv, v3 * inv); }
        bf16_t* orow = OP + (size_t)tq * 1024 + h_ * 64 + 8 * hh;
#pragma unroll
        for (int k = 0; k < 8; k += 2) {
            auto rx = __builtin_amdgcn_permlane32_swap(pk8[k].x, pk8[k + 1].x, false, false);
            auto ry = __builtin_amdgcn_permlane32_swap(pk8[k].y, pk8[k + 1].y, false, false);
            u32x4 w; w.x = rx[0]; w.y = ry[0]; w.z = rx[1]; w.w = ry[1];
            *(u32x4*)(orow + 8 * k) = w; }
            bu = nbu;
    }
#undef ATT_DECODE
#undef ATT_FETCH
    asm volatile("s_waitcnt lgkmcnt(0)" ::: "memory"); __builtin_amdgcn_s_barrier();
}

constexpr int LRU_WL = 17408;
__device__ __forceinline__ void lru_unit(LAS unsigned char* wl, const bf16_t* __restrict__ U, const bf16_t* __restrict__ GL, const bf16_t* __restrict__ WRT, const bf16_t* __restrict__ WIT,
                                         const float* __restrict__ conv_w, const float* __restrict__ conv_b, const float* __restrict__ b_r, const float* __restrict__ b_i,
                                         const float* __restrict__ lam, unsigned long long* TOT, bf16_t* __restrict__ MX, int c, int nb, int lane) {
    unsigned long long* TOT2 = TOT - (WS_TOT - WS_TOT2) / 8;
    const int t0 = 64 * c, ch0 = 64 * nb;
    const int rs = lane >> 3, chn = lane & 7;
    LAS unsigned char* xcb = wl + 9216;
#pragma unroll
    for (int i = 0; i < 9; ++i) { const int row = 8 * i + rs; const int tok = t0 - 3 + row;
        u32x4 v = (u32x4){0u, 0u, 0u, 0u};
        if (row < 67 && tok >= 0) v = __builtin_nontemporal_load((const u32x4*)(U + (size_t)tok * 1024 + ch0 + 8 * chn));
        *(LAS u32x4*)(wl + row * 128 + chn * 16) = v; }
    {
    float cw[4][8], cbv[8];
    { const float* wp = conv_w + ch0 + 8 * chn;
#pragma unroll
      for (int j = 0; j < 4; ++j) { const f32x4 a = *(const f32x4*)(wp + j * 1024), b = *(const f32x4*)(wp + j * 1024 + 4);
          cw[j][0] = a[0]; cw[j][1] = a[1]; cw[j][2] = a[2]; cw[j][3] = a[3]; cw[j][4] = b[0]; cw[j][5] = b[1]; cw[j][6] = b[2]; cw[j][7] = b[3]; }
      const f32x4 a = *(const f32x4*)(conv_b + ch0 + 8 * chn), b = *(const f32x4*)(conv_b + ch0 + 8 * chn + 4);
      cbv[0] = a[0]; cbv[1] = a[1]; cbv[2] = a[2]; cbv[3] = a[3]; cbv[4] = b[0]; cbv[5] = b[1]; cbv[6] = b[2]; cbv[7] = b[3]; }
    LDS_WAIT();
#pragma unroll 2
    for (int i = 0; i < 8; ++i) { const int t = 8 * i + rs;
        float xo[8];
#pragma unroll
        for (int e = 0; e < 8; ++e) xo[e] = cbv[e];
#pragma unroll
        for (int j = 0; j < 4; ++j) { const u32x4 uv = *(const LAS u32x4*)(wl + (t + j) * 128 + chn * 16);
            xo[0] += cw[j][0] * bflo(uv.x); xo[1] += cw[j][1] * bfhi(uv.x); xo[2] += cw[j][2] * bflo(uv.y); xo[3] += cw[j][3] * bfhi(uv.y);
            xo[4] += cw[j][4] * bflo(uv.z); xo[5] += cw[j][5] * bfhi(uv.z); xo[6] += cw[j][6] * bflo(uv.w); xo[7] += cw[j][7] * bfhi(uv.w); }
        u32x4 w; w.x = cvtpk(xo[0], xo[1]); w.y = cvtpk(xo[2], xo[3]); w.z = cvtpk(xo[4], xo[5]); w.w = cvtpk(xo[6], xo[7]);
        *(LAS u32x4*)(xcb + t * 128 + ((chn ^ ((t >> 1) & 7)) << 4)) = w; }
    LDS_WAIT();
    }
    {
        u32x4 gv[8];
#pragma unroll
        for (int i = 0; i < 8; ++i) gv[i] = *(const u32x4*)(GL + (size_t)(t0 + 8 * i + rs) * 1024 + ch0 + 8 * chn);
#pragma unroll
        for (int i = 0; i < 8; ++i) *(LAS u32x4*)(wl + (8 * i + rs) * 144 + chn * 16) = gv[i];
    }
    const int n = lane & 31, hh = lane >> 5;
#pragma unroll 1
    for (int jt = 0; jt < 2; ++jt) {
        const int chl = 32 * jt + n, ch = ch0 + chl;
        unsigned xb4[4];
#pragma unroll
        for (int q = 0; q < 4; ++q) { const int C = (q & 1) | ((q >> 1) << 2); xb4[q] = 9216u + hh * 512 + ((((chl >> 3) ^ (2 * hh)) ^ C) << 4) + (chl & 7) * 2; }
        bf16x8 bfr[2][4];
#pragma unroll
        for (int ks = 0; ks < 4; ++ks) { const size_t o = (size_t)nb * 4096 + (size_t)chl * 64 + 16 * ks + 8 * hh;
            bfr[0][ks] = *(const bf16x8*)(WRT + o); bfr[1][ks] = *(const bf16x8*)(WIT + o); }
        const float brv = b_r[ch], biv = b_i[ch], lsv = -8.0f * log1pf(expf(-lam[ch]));
        f32x16 av[2], bv[2];
        float s = 0.f, Atot = 1.f;
#pragma unroll
        for (int mt = 0; mt < 2; ++mt) {
            f32x16 ar, ai;
#pragma unroll
            for (int i = 0; i < 16; ++i) { ar[i] = 0.f; ai[i] = 0.f; }
            { const int row = 32 * mt + n;
#pragma unroll
              for (int ks = 0; ks < 4; ++ks) { const bf16x8 af = *(const LAS bf16x8*)(xcb + row * 128 + (((2 * ks + hh) ^ ((row >> 1) & 7)) << 4));
                  ar = MFMA32(af, bfr[0][ks], ar); ai = MFMA32(af, bfr[1][ks], ai); } }
#pragma unroll
            for (int rg = 0; rg < 16; ++rg) { const int tl = 32 * mt + (rg & 3) + 8 * (rg >> 2);
                const int q = (((rg >> 2) & 1) << 1) | ((rg & 3) >> 1);
                const float xc = bf2f(*(const LAS unsigned short*)(wl + xb4[q] + tl * 128));
                const float rr = fsigmoid(ar[rg] + brv); const float iv = fsigmoid(ai[rg] + biv);
                const float a_ = __expf(rr * lsv);
                const float b_ = __builtin_amdgcn_sqrtf(fmaxf(1.0f - a_ * a_, 0.f)) * iv * xc;
                ar[rg] = a_; ai[rg] = b_; }
            av[mt] = ar; bv[mt] = ai;
#pragma unroll
            for (int g = 0; g < 4; ++g) { float A = 1.f, B = 0.f;
#pragma unroll
                for (int e = 0; e < 4; ++e) { B = ar[4 * g + e] * B + ai[4 * g + e]; A = ar[4 * g + e] * A; }
                const float pA = __shfl_xor(A, 32), pB = __shfl_xor(B, 32);
                const float A0 = hh ? pA : A, B0 = hh ? pB : B, A1 = hh ? A : pA, B1 = hh ? B : pB;
                s = A1 * (A0 * s + B0) + B1; Atot = Atot * A0 * A1; }
        }
        if (hh == 0) { const unsigned long long gq = ((unsigned long long)__float_as_uint(s) << 32) | (unsigned long long)__float_as_uint(fmaxf(Atot, 1e-30f));
            __hip_atomic_store(TOT + (size_t)c * 1024 + ch, gq, __ATOMIC_RELAXED, __HIP_MEMORY_SCOPE_AGENT); }
        float fA = 1.f, fB = 0.f;
        {
            const int sc = c >> 4, rr_ = c & 15;
            const int cnt = hh ? rr_ : sc;
            unsigned long long* tp = hh ? (TOT + (size_t)(16 * sc) * 1024 + ch) : (TOT2 + ch);
            bool need_pub = (rr_ == 15);
            const float ownA = Atot, ownB = s;
            unsigned long long g[16];
            for (unsigned spins = 0;; ++spins) { bool ok = true;
#pragma unroll
                for (int k = 0; k < 16; ++k) { g[k] = 0x3f800000ull;
                    if (k < cnt) { g[k] = __hip_atomic_load(tp + (size_t)k * 1024, __ATOMIC_RELAXED, __HIP_MEMORY_SCOPE_AGENT); ok = ok && ((unsigned)g[k] != 0u); } }
                const unsigned long long okm = __builtin_amdgcn_ballot_w64(ok);
                if (need_pub && (unsigned)(okm >> 32) == 0xffffffffu) {
                    float tA = 1.f, tB = 0.f;
#pragma unroll
                    for (int k = 0; k < 16; ++k) { const float A = __uint_as_float((unsigned)g[k]), B = __uint_as_float((unsigned)(g[k] >> 32)); tB = A * tB + B; tA = A * tA; }
                    if (hh) { const unsigned long long gq = ((unsigned long long)__float_as_uint(ownA * tB + ownB) << 32) | (unsigned long long)__float_as_uint(fmaxf(ownA * tA, 1e-30f));
                        __hip_atomic_store(TOT2 + (size_t)sc * 1024 + ch, gq, __ATOMIC_RELAXED, __HIP_MEMORY_SCOPE_AGENT); }
                    need_pub = false;
                }
                if (okm == ~0ull || spins > (1u << 20)) break;
                __builtin_amdgcn_s_sleep(4);
            }
#pragma unroll
            for (int k = 0; k < 16; ++k) { const float A = __uint_as_float((unsigned)g[k]), B = __uint_as_float((unsigned)(g[k] >> 32)); fB = A * fB + B; fA = A * fA; }
        }
        s = __shfl(fA, 32 + n) * __shfl(fB, n) + __shfl(fB, 32 + n);
#pragma unroll
        for (int mt = 0; mt < 2; ++mt) {
            float sin_[4];
#pragma unroll
            for (int g = 0; g < 4; ++g) { float A = 1.f, B = 0.f;
#pragma unroll
                for (int e = 0; e < 4; ++e) { B = av[mt][4 * g + e] * B + bv[mt][4 * g + e]; A = av[mt][4 * g + e] * A; }
                const float pA = __shfl_xor(A, 32), pB = __shfl_xor(B, 32);
                const float A0 = hh ? pA : A, B0 = hh ? pB : B, A1 = hh ? A : pA, B1 = hh ? B : pB;
                const float mid = A0 * s + B0; sin_[g] = hh ? mid : s; s = A1 * mid + B1; }
            LAS unsigned char* gbase = wl + (4 * hh) * 144 + chl * 2;
#pragma unroll
            for (int g = 0; g < 4; ++g) { float hv = sin_[g];
#pragma unroll
                for (int e = 0; e < 4; ++e) { const int rg = 4 * g + e; hv = av[mt][rg] * hv + bv[mt][rg];
                    LAS unsigned short* gp = (LAS unsigned short*)(gbase + (32 * mt + e + 8 * g) * 144);
                    const float ov = hv * fsilu(bf2f(*gp));
                    *gp = (unsigned short)(cvtpk(ov, 0.f) & 0xffffu); } }
        }
    }
    LDS_WAIT();
#pragma unroll
    for (int i = 0; i < 8; ++i) { const u32x4 v = *(const LAS u32x4*)(wl + (8 * i + rs) * 144 + chn * 16);
        __builtin_amdgcn_raw_buffer_store_b128(v, __builtin_amdgcn_make_buffer_rsrc((void*)MX, (short)0, (int)((size_t)S * 2048 * 2), 0x00020000), (int)(((size_t)(t0 + 8 * i + rs) * 2048 + 1024 + ch0 + 8 * chn) * 2), 0, 16); }
    LDS_WAIT();
}

#define XB_TMO      128
#define XB_XCNT(j)  (256  + 64 * (j))
#define XB_XSUB(j)  (1280 + 64 * (j))
#define XB_XGEN(j)  (2304 + 64 * (j))
#define XB_TOP      3328
#define XB_TOPGEN   3392
#define XCD_BAR_WORDS 3456
#define XB_SPIN_CAP (1u << 18)
__device__ __forceinline__ unsigned xb_ld(unsigned* p)              { return __hip_atomic_load(p, __ATOMIC_RELAXED, __HIP_MEMORY_SCOPE_AGENT); }
__device__ __forceinline__ unsigned xb_add(unsigned* p, unsigned v) { return __hip_atomic_fetch_add(p, v, __ATOMIC_RELAXED, __HIP_MEMORY_SCOPE_AGENT); }
__device__ __forceinline__ unsigned xb_xcc_id() { return (unsigned)__builtin_amdgcn_s_getreg((3 << 11) | 20) & 0xFu; }
#define XB_SPIN(cond, bar) do { unsigned _sp = 0; while (cond) { __builtin_amdgcn_s_sleep(1); \
    if ((++_sp & 255u) == 0u) { if (xb_ld(&(bar)[XB_TMO])) break; if (_sp > XB_SPIN_CAP) { atomicAdd(&(bar)[XB_TMO], 1u); break; } } } } while (0)
struct XcdBarrier { unsigned* bar; unsigned x; volatile LAS unsigned* st; };
__device__ __forceinline__ XcdBarrier xcd_barrier_post(unsigned* bar, volatile LAS unsigned* st) {
    XcdBarrier b; b.bar = bar; b.x = xb_xcc_id(); b.st = st;
    if (threadIdx.x == 0) (void)xb_add(&bar[XB_XCNT(b.x)], 1u);
    return b;
}
__device__ __forceinline__ void xcd_barrier_complete(unsigned* bar, unsigned x, unsigned& nloc, unsigned& nx) {
    const unsigned G = gridDim.x * gridDim.y * gridDim.z;
    unsigned sum, cnt, mine, sp = 0u;
    for (;;) {
        sum = 0u; cnt = 0u; mine = 0u;
#pragma unroll
        for (unsigned j = 0; j < 16; ++j) { const unsigned c = xb_ld(&bar[XB_XCNT(j)]); sum += c; cnt += (c > 0u) ? 1u : 0u; mine = (j == x) ? c : mine; }
        if (sum == G) break;
        __builtin_amdgcn_s_sleep(1);
        if ((++sp & 255u) == 0u) { if (xb_ld(&bar[XB_TMO])) break; if (sp > XB_SPIN_CAP) { atomicAdd(&bar[XB_TMO], 1u); break; } }
    }
    nloc = mine > 0u ? mine : 1u; nx = cnt > 0u ? cnt : 1u;
}
__device__ __forceinline__ void xcd_barrier(const XcdBarrier& b) {
    asm volatile("s_waitcnt vmcnt(0)" ::: "memory");
    __syncthreads();
    if (threadIdx.x == 0) {
        unsigned* bar = b.bar;
        __builtin_amdgcn_s_waitcnt(0);
        unsigned nloc = b.st[0], nx = b.st[1];
        if (nloc == 0u) { xcd_barrier_complete(bar, b.x, nloc, nx); b.st[0] = nloc; b.st[1] = nx; }
        const unsigned old = xb_add(&bar[XB_XSUB(b.x)], 1u);
        const unsigned gen = old / nloc;
        if (old + 1u == (gen + 1u) * nloc) {
            __builtin_amdgcn_fence(__ATOMIC_RELEASE, "agent");
            asm volatile("s_waitcnt vmcnt(0)" ::: "memory");
            const unsigned og = xb_add(&bar[XB_TOP], 1u);
            const unsigned tg = og / nx;
            if (og + 1u == (tg + 1u) * nx) xb_add(&bar[XB_TOPGEN], 1u);
            else XB_SPIN(xb_ld(&bar[XB_TOPGEN]) == tg, bar);
            __builtin_amdgcn_fence(__ATOMIC_ACQUIRE, "agent");
            xb_add(&bar[XB_XGEN(b.x)], 1u);
            asm volatile("s_waitcnt vmcnt(0)" ::: "memory");
        } else {
            XB_SPIN(xb_ld(&bar[XB_XGEN(b.x)]) == gen, bar);
            __builtin_amdgcn_fence(__ATOMIC_ACQUIRE, "agent");
            asm volatile("s_waitcnt vmcnt(0)" ::: "memory");
        }
    }
    __syncthreads();
}

struct Args {
    const float *x, *c, *norm_gain, *w_ada, *b_ada, *w_in, *conv_w, *conv_b, *w_rgate, *b_rgate, *w_igate, *b_igate, *lru_lambda, *w_out, *final_gain;
    float* out; unsigned char* ws; int ph_lo, ph_hi, coop, pad;
};

__global__ void __launch_bounds__(NWAVES * 64, 2) hymba_fwd(Args a) {
    extern __shared__ __attribute__((aligned(16))) unsigned char lds_raw[];
    LAS unsigned char* lds = (LAS unsigned char*)lds_raw;
    const int tid = threadIdx.x, lane = tid & 63, wave = __builtin_amdgcn_readfirstlane(tid >> 6);
    const int G = gridDim.x; const int bx = blockIdx.x;
    const int vcu = (G % 8 == 0) ? (bx % 8) * (G / 8) + bx / 8 : bx;
    const int gw = vcu * NWAVES + wave, NGW = G * NWAVES;
    unsigned char* ws = a.ws;
    float* mod = (float*)(ws + WS_MOD);
    bf16_t* WRT = (bf16_t*)(ws + WS_WRT); bf16_t* WIT = (bf16_t*)(ws + WS_WIT);
    unsigned long long* TOT = (unsigned long long*)(ws + WS_TOT);
    bf16_t* WIN = (bf16_t*)(ws + WS_WIN); bf16_t* WOUT = (bf16_t*)(ws + WS_WOUT);
    bf16_t* HB = (bf16_t*)(ws + WS_H); bf16_t* MX = HB;
    bf16_t* PJ = (bf16_t*)(ws + WS_PROJ);
    bf16_t* OPB = (bf16_t*)(ws + WS_OP); float* LSEB = (float*)(ws + WS_LSE);
    const int lo = a.ph_lo, hi = a.ph_hi;
    volatile LAS unsigned* xst = (volatile LAS unsigned*)(lds + 143360);
    if (tid < 2) xst[tid] = 0u;
    __syncthreads();
    XcdBarrier xbar; xbar.bar = (unsigned*)ws; xbar.x = 0; xbar.st = xst;
    if (a.coop == 1) xbar = xcd_barrier_post((unsigned*)ws, xst);
#define IN(k) (lo <= (k) && (k) < hi)
#ifndef REP_A
#define REP_A 1
#endif
#ifndef REP_B
#define REP_B 1
#endif
#ifndef REP_S
#define REP_S 1
#endif
#ifndef REP_G
#define REP_G 1
#endif
#ifndef REP_H
#define REP_H 1
#endif
#define SEAM(k) do { if (a.coop && IN(k) && IN((k) + 1)) { for (int rs_ = 0; rs_ < REP_S; ++rs_) { xcd_barrier(xbar); } } } while (0)

    for (int rep_ = 0; rep_ < REP_A; ++rep_) if (IN(0)) {
        { unsigned long long* z = (unsigned long long*)(ws + WS_TOT); const size_t me = (size_t)bx * (NWAVES * 64) + tid, T = (size_t)G * (NWAVES * 64);
          for (size_t q = me; q < (size_t)128 * 1024; q += T) z[q] = 0ull;
          unsigned long long* z2 = (unsigned long long*)(ws + WS_TOT2);
          for (size_t q = me; q < (size_t)8 * 1024; q += T) z2[q] = 0ull; }
        for (int grp = bx; grp < PW / 32; grp += G) {
            const int sub = lane >> 3, ch = lane & 7;
            f32x4 acc = (f32x4){0.f, 0.f, 0.f, 0.f};
            const float* wp = a.w_ada + (size_t)(256 * wave + sub) * PW + 32 * grp + 4 * ch;
#pragma unroll 8
            for (int i = 0; i < 32; ++i) { const float cv = a.c[256 * wave + 8 * i + sub]; const float ca = cv * fsigmoid(cv);
                const f32x4 w4 = __builtin_nontemporal_load((const f32x4*)(wp + (size_t)(8 * i) * PW)); acc += ca * w4; }
#pragma unroll
            for (int e = 0; e < 4; ++e) { float v = acc[e]; v += __shfl_xor(v, 8); v += __shfl_xor(v, 16); v += __shfl_xor(v, 32); acc[e] = v; }
            LAS float* red = (LAS float*)lds;
            if (lane < 8) {
#pragma unroll
                for (int e = 0; e < 4; ++e) red[wave * 32 + 4 * lane + e] = acc[e]; }
            __syncthreads();
            if (tid < 32) { float s = a.b_ada[32 * grp + tid];
#pragma unroll
                for (int w = 0; w < 8; ++w) s += red[w * 32 + tid];
                mod[32 * grp + tid] = s; }
            __syncthreads();
        }
        LAS float* scr = (LAS float*)(lds + wave * 16384);
        constexpr int I_IN = (DM / 64) * (PW / 32), I_OUT = (DM / 64) * (DM / 32), I_G = 32;
        const int ngv = (PW / 32) < G ? (PW / 32) : G;
        const int NV = ngv * NWAVES + (G - ngv) * NWAVES * 2;
        const int nv = bx < ngv ? 1 : 2, vw0 = bx < ngv ? bx * NWAVES + wave : ngv * NWAVES + (bx - ngv) * NWAVES * 2 + wave * 2;
        for (int v = 0; v < nv; ++v)
        for (int it = vw0 + v; it < I_IN + I_OUT + 2 * I_G; it += NV) {
            int r = it;
            if (r < I_IN) { transpose_item(a.w_in, DM, PW, WIN, scr, r, lane); continue; } r -= I_IN;
            if (r < I_OUT) { transpose_item(a.w_out, DM, DM, WOUT, scr, r, lane); continue; } r -= I_OUT;
            if (r < I_G) { transpose_item(a.w_rgate + (size_t)(r >> 1) * 4096, 64, 64, WRT + (size_t)(r >> 1) * 4096, scr, r & 1, lane); continue; } r -= I_G;
            transpose_item(a.w_igate + (size_t)(r >> 1) * 4096, 64, 64, WIT + (size_t)(r >> 1) * 4096, scr, r & 1, lane);
        }
    }
    SEAM(0);
    for (int rep_ = 0; rep_ < REP_A; ++rep_) if (IN(1)) {
        f32x4 gs[8], sh[8];
#pragma unroll
        for (int j = 0; j < 8; ++j) { const int col = 4 * lane + 256 * j; const f32x4 g = *(const f32x4*)(a.norm_gain + col); const f32x4 sc = *(const f32x4*)(mod + DM + col);
            gs[j] = g * (sc + 1.0f); sh[j] = *(const f32x4*)(mod + col); }
        for (int row = gw; row < S; row += NGW) {
            const f32x4* xr = (const f32x4*)(a.x + (size_t)row * DM) + lane;
            f32x4 v[8]; float ss = 0.f;
#pragma unroll
            for (int j = 0; j < 8; ++j) { v[j] = __builtin_nontemporal_load(xr + 64 * j); ss += (v[j].x * v[j].x + v[j].y * v[j].y) + (v[j].z * v[j].z + v[j].w * v[j].w); }
            const float rstd = rsqrtf(wave_sum(ss) * (1.0f / DM) + EPS);
            u32x2* o8 = (u32x2*)(HB + (size_t)row * DM) + lane;
#pragma unroll
            for (int j = 0; j < 8; ++j) { const f32x4 hv = v[j] * rstd * gs[j] + sh[j]; u32x2 w; w.x = cvtpk(hv.x, hv.y); w.y = cvtpk(hv.z, hv.w); o8[64 * j] = w; }
        }
    }
    SEAM(1);
    for (int rep_ = 0; rep_ < REP_G; ++rep_) if (IN(2)) {
        pg8::Gemm g{HB, WIN, S, PW, DM}; pg8::StaticOrder So; So.init(S, PW, G, bx);
        pg8::EpiBf16 E{PJ, 1024, 1024, PROJ_STRIDE, QSCALE};
        pg8::gemm_phase<pg8::EpiBf16, pg8::StaticOrder, true, true>(lds, g, So, E);
    }
    SEAM(2);
    for (int rep_ = 0; rep_ < REP_B; ++rep_) if (IN(3)) {
        { LAS unsigned char* wl = lds + wave * LRU_WL;
          for (int u = gw; u < 128 * 16; u += NGW) lru_unit(wl, PJ + 4 * PROJ_STRIDE, PJ + 5 * PROJ_STRIDE, WRT, WIT, a.conv_w, a.conv_b, a.b_rgate, a.b_igate, a.lru_lambda, TOT, MX, u >> 4, u & 15, lane); }
        __syncthreads();
        attn_phase(lds, PJ, PJ + PROJ_STRIDE, PJ + 2 * PROJ_STRIDE, OPB, LSEB, (unsigned*)ws + 8192, wave, lane, tid);
    }
    SEAM(3);
    for (int rep_ = 0; rep_ < REP_B; ++rep_) if (IN(4)) {
        const bf16_t* GA = PJ + 3 * PROJ_STRIDE;
        for (int e = gw * 64 + lane; e < S * 128; e += NGW * 64) { const int t = e >> 7, c8 = e & 127, hd = c8 >> 3;
            const float l0 = LSEB[(size_t)t * 16 + hd], l1 = LSEB[(size_t)S * 16 + (size_t)t * 16 + hd], l2 = LSEB[(size_t)2 * S * 16 + (size_t)t * 16 + hd];
            const float mx = fmaxf(l0, fmaxf(l1, l2));
            float w0 = __builtin_amdgcn_exp2f(l0 - mx), w1 = __builtin_amdgcn_exp2f(l1 - mx), w2 = __builtin_amdgcn_exp2f(l2 - mx);
            const float wi = __builtin_amdgcn_rcpf(w0 + w1 + w2); w0 *= wi; w1 *= wi; w2 *= wi;
            const size_t off = (size_t)t * 1024 + 8 * c8;
            const u32x4 a0 = __builtin_nontemporal_load((const u32x4*)(OPB + off)), a1 = __builtin_nontemporal_load((const u32x4*)(OPB + PROJ_STRIDE + off)), a2 = __builtin_nontemporal_load((const u32x4*)(OPB + 2 * PROJ_STRIDE + off)), gg = __builtin_nontemporal_load((const u32x4*)(GA + off));
            u32x4 o;
#pragma unroll
            for (int k = 0; k < 4; ++k) { const float lo = (w0 * bflo(a0[k]) + w1 * bflo(a1[k]) + w2 * bflo(a2[k])) * fsilu(bflo(gg[k])); const float hi = (w0 * bfhi(a0[k]) + w1 * bfhi(a1[k]) + w2 * bfhi(a2[k])) * fsilu(bfhi(gg[k]));
                o[k] = cvtpk(lo, hi); }
            __builtin_amdgcn_raw_buffer_store_b128(o, __builtin_amdgcn_make_buffer_rsrc((void*)MX, (short)0, (int)((size_t)S * 2048 * 2), 0x00020000), (int)(((size_t)t * 2048 + 8 * c8) * 2), 0, 16); }
    }
    SEAM(4);
    const bool fused_final = (G == 256);
    if (IN(5)) {
        __syncthreads();
        pg8::Gemm g{MX, WOUT, S, DM, DM}; pg8::StaticOrder So; So.init(S, DM, G, bx);
        if (fused_final) {
            pg8::EpiFinal E{a.x, mod + 2 * DM, a.final_gain, a.out, DM, (float*)(ws + WS_SLOT), (unsigned*)ws + 4096};
            pg8::gemm_phase<pg8::EpiFinal, pg8::StaticOrder, false, true>(lds, g, So, E);
        } else {
            pg8::EpiResGate E{a.x, mod + 2 * DM, a.out, DM};
            pg8::gemm_phase<pg8::EpiResGate, pg8::StaticOrder, true, true>(lds, g, So, E);
        }
    }
    if (!fused_final) SEAM(5);
    if (IN(6) && !fused_final) {
        f32x4 fg[8];
#pragma unroll
        for (int j = 0; j < 8; ++j) fg[j] = *(const f32x4*)(a.final_gain + 4 * lane + 256 * j);
        for (int row = gw; row < S; row += NGW) {
            f32x4* yr = (f32x4*)(a.out + (size_t)row * DM) + lane;
            f32x4 v[8]; float ss = 0.f;
#pragma unroll
            for (int j = 0; j < 8; ++j) { v[j] = yr[64 * j]; ss += (v[j].x * v[j].x + v[j].y * v[j].y) + (v[j].z * v[j].z + v[j].w * v[j].w); }
            const float rstd = rsqrtf(wave_sum(ss) * (1.0f / DM) + EPS);
#pragma unroll
            for (int j = 0; j < 8; ++j) yr[64 * j] = v[j] * rstd * fg[j];
        }
    }
#undef IN
#undef SEAM
}

#ifndef MK_MULTI
#define MK_MULTI 0
#endif
extern "C" void kernel_launch(void* const* d_in, const int* in_sizes, int n_in, void* d_out, int out_size, void* d_ws, size_t ws_size, hipStream_t stream) {
    static int grid = 0;
    if (grid == 0) {
        int dev = 0, cus = 0, per_cu = 0;
        hipGetDevice(&dev);
        hipDeviceGetAttribute(&cus, hipDeviceAttributeMultiprocessorCount, dev);
        hipFuncSetAttribute((const void*)hymba_fwd, hipFuncAttributeMaxDynamicSharedMemorySize, LDS_BYTES);
        hipOccupancyMaxActiveBlocksPerMultiprocessor(&per_cu, (const void*)hymba_fwd, NWAVES * 64, LDS_BYTES);
        if (per_cu < 1) { fprintf(stderr, "kernel_launch: occupancy query returned %d\n", per_cu); per_cu = 1; }
        (void)hipGetLastError();
        grid = cus * per_cu;
    }
    (void)hipMemsetAsync(d_ws, 0, 40960, stream);
    Args a{};
    a.x = (const float*)d_in[0]; a.c = (const float*)d_in[1]; a.norm_gain = (const float*)d_in[2]; a.w_ada = (const float*)d_in[3]; a.b_ada = (const float*)d_in[4];
    a.w_in = (const float*)d_in[5]; a.conv_w = (const float*)d_in[6]; a.conv_b = (const float*)d_in[7]; a.w_rgate = (const float*)d_in[8]; a.b_rgate = (const float*)d_in[9];
    a.w_igate = (const float*)d_in[10]; a.b_igate = (const float*)d_in[11]; a.lru_lambda = (const float*)d_in[12]; a.w_out = (const float*)d_in[13]; a.final_gain = (const float*)d_in[14];
    a.out = (float*)d_out; a.ws = (unsigned char*)d_ws; a.pad = 0;
#if MK_MULTI
    for (int p = 0; p < NPH; ++p) { a.ph_lo = p; a.ph_hi = p + 1; a.coop = 0; hipLaunchKernelGGL(hymba_fwd, dim3(grid), dim3(NWAVES * 64), LDS_BYTES, stream, a); }
#else
    a.ph_lo = 0; a.ph_hi = NPH; a.coop = 1;
    void* args[] = {&a};
    hipError_t e = hipLaunchCooperativeKernel((const void*)hymba_fwd, dim3(grid), dim3(NWAVES * 64), args, LDS_BYTES, stream);
    if (e != hipSuccess) fprintf(stderr, "launch failed: %s (grid %d)\n", hipGetErrorString(e), grid);
#endif
}
```

```cpp
#include <hip/hip_runtime.h>
#include <hip/hip_cooperative_groups.h>
#include <cstdio>
#include <cstdint>
namespace cg = cooperative_groups;

#define LAS __attribute__((address_space(3)))
typedef unsigned short bf16_t;
typedef short bf16x8 __attribute__((ext_vector_type(8)));
typedef short s16x4 __attribute__((ext_vector_type(4)));
typedef float f32x4 __attribute__((ext_vector_type(4)));
typedef float f32x16 __attribute__((ext_vector_type(16)));
typedef unsigned u32x4 __attribute__((ext_vector_type(4)));
typedef unsigned u32x2 __attribute__((ext_vector_type(2)));
typedef float f32x2_t __attribute__((ext_vector_type(2)));
typedef __bf16 bf16x2_t __attribute__((ext_vector_type(2)));
typedef short v4i16_t __attribute__((ext_vector_type(4)));

constexpr int S = 8192, DM = 2048, PW = 6144, AW = 1024, NH = 16;
constexpr float EPS = 1e-6f;
constexpr float LOG2E = 1.4426950408889634f;
constexpr float QSCALE = 0.125f * LOG2E;
constexpr int NWAVES = 8;
constexpr int LDS_BYTES = 147456;
constexpr int NPH = 7;

constexpr size_t MiB = 1u << 20;
constexpr size_t WS_MOD = 1 * MiB;
constexpr size_t WS_WRT = 1 * MiB + 65536;
constexpr size_t WS_WIT = WS_WRT + 131072;
constexpr size_t WS_TOT2 = 1 * MiB + 512 * 1024;
constexpr size_t WS_TOT = 2 * MiB;
constexpr size_t WS_WIN = 4 * MiB;
constexpr size_t WS_WOUT = 28 * MiB;
constexpr size_t WS_H = 36 * MiB;
constexpr size_t WS_PROJ = 68 * MiB;
constexpr size_t PROJ_STRIDE = (size_t)S * 1024;
constexpr size_t WS_OP = 164 * MiB;
constexpr size_t WS_SLOT = 3 * MiB;
constexpr size_t WS_LSE = 212 * MiB;

__device__ __forceinline__ unsigned cvtpk(float lo, float hi) { f32x2_t v = {lo, hi}; bf16x2_t b = __builtin_convertvector(v, bf16x2_t); return __builtin_bit_cast(unsigned, b); }
__device__ __forceinline__ float bf2f(unsigned short u) { return __uint_as_float((unsigned)u << 16); }
__device__ __forceinline__ float bflo(unsigned u) { return __uint_as_float(u << 16); }
__device__ __forceinline__ float bfhi(unsigned u) { return __uint_as_float(u & 0xffff0000u); }
__device__ __forceinline__ float fsigmoid(float x) { return __builtin_amdgcn_rcpf(1.0f + __expf(-x)); }
__device__ __forceinline__ float fsilu(float x) { return x * fsigmoid(x); }
__device__ __forceinline__ float wave_sum(float v) {
#pragma unroll
    for (int o = 1; o < 64; o <<= 1) v += __shfl_xor(v, o);
    return v;
}

namespace pg8 {
#define PG8_LAS __attribute__((address_space(3)))
constexpr int BM = 256, BK = 64, HALF = 128, HTB = HALF * BK * 2, STAGE_BYTES = 8 * HTB, NXCD = 8, WGM = 8;
__host__ __device__ __forceinline__ int lds_byte(int r, int c) { const int st = (r >> 4) * 2 + (c >> 5), rr = r & 15, cc = c & 31, ob = rr * 64 + cc * 2; return st * 1024 + (ob ^ (((ob >> 9) & 1) << 5)); }
__host__ __device__ __forceinline__ void stage_rc(int b, int& R, int& C) { const int st = b / 1024, sb = b % 1024, swz = sb ^ (((sb >> 9) & 1) << 5); R = (st >> 1) * 16 + swz / 64; C = (st & 1) * 32 + (swz % 64) / 2; }
__host__ __device__ __forceinline__ int perm32(int rho) { const int n = rho >> 4, i = rho & 15; return 8 * (i >> 2) + 4 * n + (i & 3); }
struct Unit { int pm, pn; };
struct Gemm { const bf16_t* A; const bf16_t* Bt; int M, N, K; };
struct StaticOrder {
    int nM, nN, nwg, G, c;
    __host__ __device__ void init(int M, int N, int G_, int c_) { nM = M / BM; nN = N / BM; nwg = nM * nN; G = G_; c = c_; }
    __host__ __device__ bool next(int i, Unit& u) const {
        const long L = (long)i * G + c; if (L >= nwg) return false;
        int wgid = (int)L; { const int q = nwg / NXCD, r = nwg % NXCD, xcd = wgid % NXCD, off = wgid / NXCD; wgid = (xcd < r ? xcd * (q + 1) : r * (q + 1) + (xcd - r) * q) + off; }
        const int nig = WGM * nN, gid = wgid / nig, fm = gid * WGM, gsz = (nM - fm) < WGM ? (nM - fm) : WGM;
        u.pm = fm + ((wgid % nig) % gsz); u.pn = (wgid % nig) / gsz; return true;
    }
    __device__ __forceinline__ void a_ready(const Unit&) const {}
    __device__ __forceinline__ void done(const Unit&) const {}
};
__device__ __forceinline__ unsigned cvt_pk_bf16(float lo, float hi) { unsigned r; asm volatile("v_cvt_pk_bf16_f32 %0, %1, %2" : "=v"(r) : "v"(lo), "v"(hi)); return r; }

struct EpiBf16 {
    static constexpr bool PERM = true, AFTER_DRAIN = false;
    bf16_t* O; int ldc; int split_cols; size_t split_stride; float scale0;
    __device__ __forceinline__ void operator()(const f32x4 (&acc)[2][2][4][2], const Unit& u, int wr, int wc, int fr, int fq) const {
        const int row0 = u.pm * BM + wr * 64 + fr; int colt = u.pn * BM;
        float sc = 1.f; const int t = colt / split_cols; colt -= t * split_cols; if (t == 0) sc = scale0;
        const int col0 = colt + wc * 32 + 8 * fq;
        const __amdgpu_buffer_rsrc_t rs = __builtin_amdgcn_make_buffer_rsrc((void*)O, (short)0, (int)(6 * PROJ_STRIDE * 2), 0x00020000);
        const unsigned tb = (unsigned)((size_t)t * split_stride * 2);
#pragma unroll
        for (int ai = 0; ai < 2; ++ai)
#pragma unroll
            for (int m = 0; m < 4; ++m) { const unsigned ro = tb + (unsigned)(((row0 + ai * HALF + m * 16) * ldc + col0) * 2);
#pragma unroll
                for (int bj = 0; bj < 2; ++bj) { f32x4 v0 = acc[ai][bj][m][0] * sc, v1 = acc[ai][bj][m][1] * sc;
                    u32x4 w; w.x = cvt_pk_bf16(v0[0], v0[1]); w.y = cvt_pk_bf16(v0[2], v0[3]); w.z = cvt_pk_bf16(v1[0], v1[1]); w.w = cvt_pk_bf16(v1[2], v1[3]);
                    __builtin_amdgcn_raw_buffer_store_b128(w, rs, (int)(ro + bj * HALF * 2), 0, 16); } }
    }
    __device__ __forceinline__ void fused(f32x4 (&)[2][2][4][2], const Unit&, int, int, int, int, PG8_LAS unsigned char*, int, int) const {}
};
struct EpiResGate {
    static constexpr bool PERM = false, AFTER_DRAIN = false;
    const float* x; const float* gate; float* out; int ldc;
    __device__ __forceinline__ void operator()(const f32x4 (&acc)[2][2][4][2], const Unit& u, int wr, int wc, int fr, int fq) const {
        const int col0 = u.pn * BM + wc * 32 + 4 * fq;
        f32x4 gv[2][2];
#pragma unroll
        for (int bj = 0; bj < 2; ++bj)
#pragma unroll
            for (int n = 0; n < 2; ++n) gv[bj][n] = *(const f32x4*)(gate + col0 + bj * HALF + n * 16);
#pragma unroll
        for (int ai = 0; ai < 2; ++ai)
#pragma unroll
            for (int m = 0; m < 4; ++m) { const size_t off = (size_t)(u.pm * BM + ai * HALF + wr * 64 + m * 16 + fr) * ldc + col0;
#pragma unroll
                for (int bj = 0; bj < 2; ++bj)
#pragma unroll
                    for (int n = 0; n < 2; ++n) { const f32x4 xv = *(const f32x4*)(x + off + bj * HALF + n * 16);
                        *(f32x4*)(out + off + bj * HALF + n * 16) = xv + gv[bj][n] * acc[ai][bj][m][n]; } }
    }
    __device__ __forceinline__ void fused(f32x4 (&)[2][2][4][2], const Unit&, int, int, int, int, PG8_LAS unsigned char*, int, int) const {}
};

struct EpiFinal {
    static constexpr bool PERM = false, AFTER_DRAIN = true;
    const float* x; const float* gate; const float* fg; float* out; int ldc; float* slots; unsigned* cnt;
    __device__ __forceinline__ void operator()(const f32x4 (&)[2][2][4][2], const Unit&, int, int, int, int) const {}
    __device__ __forceinline__ void fused(f32x4 (&acc)[2][2][4][2], const Unit& u, int wr, int wc, int fr, int fq, PG8_LAS unsigned char* lds, int wid, int lane) const {
        const int col0 = u.pn * BM + wc * 32 + 4 * fq;
        PG8_LAS float* P = (PG8_LAS float*)lds;
        PG8_LAS float* Sr = (PG8_LAS float*)(lds + 4096);
        {
        f32x4 gv[2][2];
#pragma unroll
        for (int bj = 0; bj < 2; ++bj)
#pragma unroll
            for (int n = 0; n < 2; ++n) gv[bj][n] = *(const f32x4*)(gate + col0 + bj * HALF + n * 16);
#pragma unroll
        for (int ai = 0; ai < 2; ++ai)
#pragma unroll
            for (int m = 0; m < 4; ++m) { const int rl = ai * HALF + wr * 64 + m * 16 + fr; const size_t off = (size_t)(u.pm * BM + rl) * ldc + col0;
                float ss = 0.f;
#pragma unroll
                for (int bj = 0; bj < 2; ++bj)
#pragma unroll
                    for (int n = 0; n < 2; ++n) { const f32x4 xv = __builtin_nontemporal_load((const f32x4*)(x + off + bj * HALF + n * 16)); const f32x4 y = xv + gv[bj][n] * acc[ai][bj][m][n];
                        acc[ai][bj][m][n] = y; ss += (y[0] * y[0] + y[1] * y[1]) + (y[2] * y[2] + y[3] * y[3]); }
                ss += __shfl_xor(ss, 16); ss += __shfl_xor(ss, 32);
                if (fq == 0) P[rl * 4 + wc] = ss; }
        }
        asm volatile("s_waitcnt lgkmcnt(0)" ::: "memory"); __builtin_amdgcn_s_barrier(); asm volatile("" ::: "memory");
        const int row = wid * 32 + (lane & 31);
        if (lane < 32) { const float t = (P[row * 4 + 0] + P[row * 4 + 1]) + (P[row * 4 + 2] + P[row * 4 + 3]);
            __hip_atomic_store(slots + (size_t)(u.pm * BM + row) * 8 + u.pn, t, __ATOMIC_RELAXED, __HIP_MEMORY_SCOPE_AGENT); }
        asm volatile("s_waitcnt vmcnt(0)" ::: "memory");
        if (lane == 0) __hip_atomic_fetch_add(cnt + 64 * u.pm, 1u, __ATOMIC_RELAXED, __HIP_MEMORY_SCOPE_AGENT);
        if (wid == 0) {
            for (unsigned spins = 0; spins < (1u << 22); ++spins) {
                if ((unsigned)__builtin_amdgcn_readfirstlane(__hip_atomic_load(cnt + 64 * u.pm, __ATOMIC_RELAXED, __HIP_MEMORY_SCOPE_AGENT)) >= 64u) break;
                __builtin_amdgcn_s_sleep(2);
            }
            __builtin_amdgcn_fence(__ATOMIC_ACQUIRE, "agent");
        }
        asm volatile("s_waitcnt vmcnt(0) lgkmcnt(0)" ::: "memory"); __builtin_amdgcn_s_barrier(); asm volatile("" ::: "memory");
        if (lane < 32) { const float* sl = slots + (size_t)(u.pm * BM + row) * 8; float t = 0.f;
#pragma unroll
            for (int k = 0; k < 8; ++k) t += __hip_atomic_load(sl + k, __ATOMIC_RELAXED, __HIP_MEMORY_SCOPE_AGENT);
            Sr[row] = rsqrtf(t * (1.0f / 2048.0f) + 1e-6f); }
        asm volatile("s_waitcnt vmcnt(0) lgkmcnt(0)" ::: "memory"); __builtin_amdgcn_s_barrier(); asm volatile("" ::: "memory");
        const __amdgpu_buffer_rsrc_t out_rs = __builtin_amdgcn_make_buffer_rsrc((void*)out, (short)0, (int)((size_t)S * 2048 * 4), 0x00020000);
        f32x4 fv[2][2];
#pragma unroll
        for (int bj = 0; bj < 2; ++bj)
#pragma unroll
            for (int n = 0; n < 2; ++n) fv[bj][n] = *(const f32x4*)(fg + col0 + bj * HALF + n * 16);
#pragma unroll
        for (int ai = 0; ai < 2; ++ai)
#pragma unroll
            for (int m = 0; m < 4; ++m) { const int rl = ai * HALF + wr * 64 + m * 16 + fr; const size_t off = (size_t)(u.pm * BM + rl) * ldc + col0; const float rstd = Sr[rl];
#pragma unroll
                for (int bj = 0; bj < 2; ++bj)
#pragma unroll
                    for (int n = 0; n < 2; ++n) { const f32x4 ov = acc[ai][bj][m][n] * rstd * fv[bj][n]; __builtin_amdgcn_raw_buffer_store_b128(__builtin_bit_cast(u32x4, ov), out_rs, (int)((off + bj * HALF + n * 16) * 4), 0, 16); } }
    }
};

template <class Epi, class Sched, bool ALIGN_EPI = false, bool SP2 = false>
__device__ __forceinline__ void gemm_phase(PG8_LAS unsigned char* lds, const Gemm g, const Sched& S, const Epi& E) {
    const int tid = threadIdx.x, wid = __builtin_amdgcn_readfirstlane(tid >> 6), lane = tid & 63, wr = wid >> 2, wc = wid & 3, fr = lane & 15, fq = lane >> 4;
    const int K = g.K, nt = K / BK;
    unsigned voffA[2], voffB[2];
#pragma unroll
    for (int i = 0; i < 2; ++i) { int R, C; stage_rc(tid * 16 + i * 8192, R, C); const int Rb = Epi::PERM ? ((R & ~31) + perm32(R & 31)) : R;
        voffA[i] = (unsigned)(R * K + C) * 2u; voffB[i] = (unsigned)(Rb * K + C) * 2u; }
    const size_t kstep = (size_t)(BK * 2);
    const size_t hstep = (size_t)HALF * K * 2;
    const size_t tstep = 2 * hstep;
    const unsigned ldsw = (unsigned)wid * 1024u;
    const int aoff = lds_byte(wr * 64 + fr, fq * 8), boff = lds_byte(wc * 32 + fr, fq * 8);
#define PG8_SA(b, h) (((b) * 2 + (h)) * HTB)
#define PG8_SB(b, h) ((4 + (b) * 2 + (h)) * HTB)
#define PG8_STAGE(bufoff, gbase, voff) do { _Pragma("unroll") for (int _i = 0; _i < 2; ++_i) \
        __builtin_amdgcn_global_load_lds((const unsigned*)((const char*)(gbase) + (voff)[_i]), (PG8_LAS unsigned*)(lds + (bufoff) + ldsw + _i * 8192), 16, 0, 0); } while (0)
#define PG8_LDA(dst, b, h) do { _Pragma("unroll") for (int m = 0; m < 4; ++m) _Pragma("unroll") for (int k = 0; k < 2; ++k) dst[m][k] = *(const PG8_LAS bf16x8*)(lds + PG8_SA(b, h) + aoff + m * 2048 + k * 1024); } while (0)
#define PG8_LDB(dst, b, h) do { _Pragma("unroll") for (int n = 0; n < 2; ++n) _Pragma("unroll") for (int k = 0; k < 2; ++k) dst[n][k] = *(const PG8_LAS bf16x8*)(lds + PG8_SB(b, h) + boff + n * 2048 + k * 1024); } while (0)
#define PG8_MMA(ai, bj, At, Bt) do { __builtin_amdgcn_s_setprio(1); _Pragma("unroll") for (int m = 0; m < 4; ++m) _Pragma("unroll") for (int n = 0; n < 2; ++n) _Pragma("unroll") for (int k = 0; k < 2; ++k) \
        acc[ai][bj][m][n] = __builtin_amdgcn_mfma_f32_16x16x32_bf16(Bt[n][k], At[m][k], acc[ai][bj][m][n], 0, 0, 0); __builtin_amdgcn_s_setprio(0); } while (0)
#define PG8_WAIT_V(n) asm volatile("s_waitcnt vmcnt(" #n ")" ::: "memory")
#define PG8_WAIT_L(n) asm volatile("s_waitcnt lgkmcnt(" #n ")" ::: "memory")
#define PG8_BAR __builtin_amdgcn_s_barrier()
#define PG8_SCHED __builtin_amdgcn_sched_barrier(0)
    Unit cur, nxt; int ui = 0;
    if (!S.next(0, cur)) return;
    f32x4 acc[2][2][4][2];
#pragma unroll
    for (int a = 0; a < 2; ++a)
#pragma unroll
        for (int b = 0; b < 2; ++b)
#pragma unroll
            for (int m = 0; m < 4; ++m)
#pragma unroll
                for (int n = 0; n < 2; ++n) acc[a][b][m][n] = (f32x4){0.f, 0.f, 0.f, 0.f};
    bf16x8 At[4][2], B0[2][2], B1[2][2];
    const char* cA = (const char*)g.A + (size_t)cur.pm * tstep; const char* cB = (const char*)g.Bt + (size_t)cur.pn * tstep;
    S.a_ready(cur);
    if constexpr (SP2) {
        PG8_STAGE(PG8_SB(0, 0), cB, voffB); PG8_STAGE(PG8_SB(0, 1), cB + hstep, voffB); PG8_STAGE(PG8_SA(0, 0), cA, voffA); PG8_STAGE(PG8_SA(0, 1), cA + hstep, voffA);
        if (wr == 1) PG8_BAR;
        PG8_WAIT_V(2); PG8_BAR;
        PG8_STAGE(PG8_SB(1, 0), cB + kstep, voffB); PG8_STAGE(PG8_SA(1, 0), cA + kstep, voffA); PG8_STAGE(PG8_SB(1, 1), cB + hstep + kstep, voffB);
        PG8_WAIT_V(6); PG8_BAR;
    } else {
        PG8_STAGE(PG8_SB(0, 0), cB, voffB); PG8_STAGE(PG8_SA(0, 0), cA, voffA); PG8_STAGE(PG8_SB(0, 1), cB + hstep, voffB); PG8_STAGE(PG8_SA(0, 1), cA + hstep, voffA);
        if (wr == 1) PG8_BAR;
        PG8_WAIT_V(4); PG8_BAR;
        PG8_STAGE(PG8_SB(1, 0), cB + kstep, voffB); PG8_STAGE(PG8_SA(1, 0), cA + kstep, voffA); PG8_STAGE(PG8_SB(1, 1), cB + hstep + kstep, voffB);
        PG8_WAIT_V(6); PG8_BAR;
    }
    for (;;) {
        const bool has_next = S.next(ui + 1, nxt);
        const char* nA = has_next ? (const char*)g.A + (size_t)nxt.pm * tstep : cA; const char* nB = has_next ? (const char*)g.Bt + (size_t)nxt.pn * tstep : cB;
        for (int t = 0; t < nt; t += 2) {
            const bool last = (t == nt - 2);
            const char* a1 = cA + (size_t)(t + 1) * kstep;
            const char* a2 = last ? nA : cA + (size_t)(t + 2) * kstep; const char* b2 = last ? nB : cB + (size_t)(t + 2) * kstep;
            const char* a3 = a2 + kstep; const char* b3 = b2 + kstep;
            if (last && has_next) S.a_ready(nxt);
            if constexpr (SP2) {
            PG8_LDB(B0, 0, 0); PG8_LDB(B1, 0, 1); PG8_SCHED; PG8_LDA(At, 0, 0); PG8_STAGE(PG8_SA(1, 1), a1 + hstep, voffA);
            PG8_WAIT_V(8); PG8_WAIT_L(0); PG8_BAR; PG8_MMA(0, 0, At, B0); PG8_MMA(0, 1, At, B1); PG8_BAR; PG8_SCHED;
            PG8_LDA(At, 0, 1); PG8_STAGE(PG8_SB(0, 0), b2, voffB); PG8_STAGE(PG8_SB(0, 1), b2 + hstep, voffB); PG8_STAGE(PG8_SA(0, 0), a2, voffA);
            PG8_WAIT_V(8); PG8_WAIT_L(0); PG8_BAR; PG8_MMA(1, 0, At, B0); PG8_MMA(1, 1, At, B1); PG8_BAR; PG8_SCHED;
            PG8_LDB(B0, 1, 0); PG8_LDB(B1, 1, 1); PG8_SCHED; PG8_LDA(At, 1, 0); PG8_STAGE(PG8_SA(0, 1), a2 + hstep, voffA);
            PG8_WAIT_V(8); PG8_WAIT_L(0); PG8_BAR; PG8_MMA(0, 0, At, B0); PG8_MMA(0, 1, At, B1); PG8_BAR; PG8_SCHED;
            PG8_LDA(At, 1, 1); PG8_STAGE(PG8_SB(1, 0), b3, voffB); PG8_STAGE(PG8_SB(1, 1), b3 + hstep, voffB); PG8_STAGE(PG8_SA(1, 0), a3, voffA);
            PG8_WAIT_V(8); PG8_WAIT_L(0); PG8_BAR; PG8_MMA(1, 0, At, B0); PG8_MMA(1, 1, At, B1); PG8_BAR; PG8_SCHED;
            } else {
            PG8_LDB(B0, 0, 0); PG8_SCHED; PG8_LDA(At, 0, 0); PG8_STAGE(PG8_SA(1, 1), a1 + hstep, voffA);
            PG8_WAIT_L(8); PG8_BAR; PG8_WAIT_L(0); PG8_MMA(0, 0, At, B0); PG8_BAR; PG8_SCHED;
            PG8_LDB(B1, 0, 1); PG8_STAGE(PG8_SB(0, 0), b2, voffB);
            PG8_BAR; PG8_WAIT_L(0); PG8_MMA(0, 1, At, B1); PG8_BAR;
            PG8_LDA(At, 0, 1); PG8_STAGE(PG8_SA(0, 0), a2, voffA);
            PG8_BAR; PG8_WAIT_L(0); PG8_MMA(1, 0, At, B0); PG8_BAR; PG8_SCHED;
            PG8_STAGE(PG8_SB(0, 1), b2 + hstep, voffB);
            PG8_WAIT_V(6); PG8_BAR; PG8_MMA(1, 1, At, B1); PG8_BAR;
            PG8_LDB(B0, 1, 0); PG8_SCHED; PG8_LDA(At, 1, 0); PG8_STAGE(PG8_SA(0, 1), a2 + hstep, voffA);
            PG8_WAIT_L(8); PG8_BAR; PG8_WAIT_L(0); PG8_MMA(0, 0, At, B0); PG8_BAR; PG8_SCHED;
            PG8_LDB(B1, 1, 1); PG8_STAGE(PG8_SB(1, 0), b3, voffB);
            PG8_BAR; PG8_WAIT_L(0); PG8_MMA(0, 1, At, B1); PG8_BAR;
            PG8_LDA(At, 1, 1); PG8_STAGE(PG8_SA(1, 0), a3, voffA);
            PG8_BAR; PG8_WAIT_L(0); PG8_MMA(1, 0, At, B0); PG8_BAR; PG8_SCHED;
            PG8_STAGE(PG8_SB(1, 1), b3 + hstep, voffB);
            PG8_WAIT_V(6); PG8_BAR; PG8_MMA(1, 1, At, B1); PG8_BAR;
            }
        }
        if constexpr (ALIGN_EPI) { if (wr == 0) PG8_BAR; }
        if constexpr (!Epi::AFTER_DRAIN) { E(acc, cur, wr, wc, fr, fq); S.done(cur); }
        if (!has_next) break;
#pragma unroll
        for (int a = 0; a < 2; ++a)
#pragma unroll
            for (int b = 0; b < 2; ++b)
#pragma unroll
                for (int m = 0; m < 4; ++m)
#pragma unroll
                    for (int n = 0; n < 2; ++n) acc[a][b][m][n] = (f32x4){0.f, 0.f, 0.f, 0.f};
        cur = nxt; cA = nA; cB = nB; ++ui;
        if constexpr (ALIGN_EPI) { if (wr == 1) PG8_BAR; }
    }
    PG8_WAIT_V(0);
    if constexpr (!ALIGN_EPI) { if (wr == 0) PG8_BAR; }
    PG8_BAR;
    if constexpr (Epi::AFTER_DRAIN) { E.fused(acc, cur, wr, wc, fr, fq, lds, wid, lane); S.done(cur); }
#undef PG8_SA
#undef PG8_SB
#undef PG8_STAGE
#undef PG8_LDA
#undef PG8_LDB
#undef PG8_MMA
#undef PG8_WAIT_V
#undef PG8_WAIT_L
#undef PG8_BAR
#undef PG8_SCHED
}
}

#define LDS_WAIT() asm volatile("s_waitcnt lgkmcnt(0)" ::: "memory")
#define MFMA32(a, b, c) __builtin_amdgcn_mfma_f32_32x32x16_bf16((a), (b), (c), 0, 0, 0)

__device__ __forceinline__ void transpose_item(const float* W, int K, int N, bf16_t* WT, LAS float* scr, int item, int lane) {
    const int nblk = N / 32, kb = item / nblk, nb = item % nblk, k0 = 64 * kb, n0 = 32 * nb;
    { const int kr = lane >> 3, c4 = lane & 7; f32x4 v[8];
#pragma unroll
      for (int i = 0; i < 8; ++i) v[i] = __builtin_nontemporal_load((const f32x4*)(W + (size_t)(k0 + 8 * i + kr) * N + n0 + 4 * c4));
#pragma unroll
      for (int i = 0; i < 8; ++i) { LAS float* d = scr + (8 * i + kr) * 33 + 4 * c4; d[0] = v[i][0]; d[1] = v[i][1]; d[2] = v[i][2]; d[3] = v[i][3]; } }
    LDS_WAIT();
    const int c = lane & 7;
    const __amdgpu_buffer_rsrc_t wt_rs = __builtin_amdgcn_make_buffer_rsrc((void*)WT, (short)0, K * N * 2, 0x00020000);
#pragma unroll
    for (int j = 0; j < 4; ++j) { const int n = (lane >> 3) + 8 * j; const LAS float* s = scr + (8 * c) * 33 + n;
        u32x4 o; o.x = cvtpk(s[0 * 33], s[1 * 33]); o.y = cvtpk(s[2 * 33], s[3 * 33]); o.z = cvtpk(s[4 * 33], s[5 * 33]); o.w = cvtpk(s[6 * 33], s[7 * 33]);
        __builtin_amdgcn_raw_buffer_store_b128(o, wt_rs, (int)(((size_t)(n0 + n) * K + k0 + 8 * c) * 2), 0, 16); }
    LDS_WAIT();
}

__device__ __forceinline__ void attn_phase(LAS unsigned char* lds, const bf16_t* __restrict__ Q, const bf16_t* __restrict__ Kb, const bf16_t* __restrict__ Vb,
                                           bf16_t* __restrict__ OPB, float* __restrict__ LSEB, unsigned* qctr, int wave, int lane, int tid) {
    const int n = lane & 31, hh = lane >> 5;
    const int prow = tid >> 3, pch = tid & 7;
    unsigned pkw[6];
#pragma unroll
    for (int i = 0; i < 6; ++i) { const int r384 = prow + 64 * i, j = r384 >> 5, row = r384 & 31; pkw[i] = j * 8192 + row * 128; }
    const unsigned kswz = (unsigned)((pch ^ ((prow >> 1) & 7)) << 4), vswz = 4096u + (unsigned)((pch ^ (((prow >> 1) & 1) << 2)) << 4);
    unsigned kr[4], vb[2];
#pragma unroll
    for (int ks = 0; ks < 4; ++ks) kr[ks] = n * 128 + (((2 * ks + hh) ^ ((n >> 1) & 7)) << 4);
    { const int gl = (lane >> 4) & 1, i16 = lane & 15, q = i16 >> 2, p = i16 & 3; const int row0 = 4 * hh + q, cb = 2 * gl + (p >> 1), sw = ((q >> 1) & 1) << 2;
#pragma unroll
      for (int dt = 0; dt < 2; ++dt) vb[dt] = 4096 + row0 * 128 + (((cb + 4 * dt) ^ sw) << 4) + 8 * (p & 1); }
    const bf16x8 ones = (bf16x8){0x3F80, 0x3F80, 0x3F80, 0x3F80, 0x3F80, 0x3F80, 0x3F80, 0x3F80};
    u32x4 pk[6], pv[6]; bf16x8 pq[4];
#define ATT_DECODE(bu_) const int p_ = (bu_) >> 9, rem_ = (bu_) & 511, h_ = rem_ >> 5, i8_ = rem_ & 31; const int dsh_ = p_ == 0 ? 4 : (p_ == 1 ? 2 : 0), gsh_ = 8 - dsh_; \
        const int rho_ = (i8_ * 8) >> gsh_, grp0_ = (i8_ * 8) & ((1 << gsh_) - 1);
#define ATT_FETCH(bu_) do { ATT_DECODE(bu_) \
        _Pragma("unroll") for (int i = 0; i < 6; ++i) { const int kp = 32 * (grp0_ - 4) + prow + 64 * i; pk[i] = (u32x4){0u, 0u, 0u, 0u}; pv[i] = pk[i]; \
            if (kp >= 0) { const size_t o_ = ((size_t)rho_ + ((size_t)kp << dsh_)) * 1024 + h_ * 64 + 8 * pch; pk[i] = *(const u32x4*)(Kb + o_); pv[i] = *(const u32x4*)(Vb + o_); } } \
        { const int tq_ = rho_ + ((32 * (grp0_ + wave) + n) << dsh_); const bf16_t* qp_ = Q + (size_t)tq_ * 1024 + h_ * 64 + 8 * hh; \
          _Pragma("unroll") for (int ks = 0; ks < 4; ++ks) pq[ks] = *(const bf16x8*)(qp_ + 16 * ks); } } while (0)
    volatile LAS int* slot = (volatile LAS int*)(lds + 98304);
    if (tid == 0) slot[0] = (int)__hip_atomic_fetch_add(qctr, 1u, __ATOMIC_RELAXED, __HIP_MEMORY_SCOPE_AGENT);
    asm volatile("s_waitcnt vmcnt(0) lgkmcnt(0)" ::: "memory"); __builtin_amdgcn_s_barrier(); asm volatile("" ::: "memory");
    int bu = slot[0];
    if (bu < 1536) ATT_FETCH(bu);
    while (bu < 1536) {
        ATT_DECODE(bu)
        asm volatile("s_waitcnt lgkmcnt(0)" ::: "memory"); __builtin_amdgcn_s_barrier();
#pragma unroll
        for (int i = 0; i < 6; ++i) { *(LAS u32x4*)(lds + pkw[i] + kswz) = pk[i]; *(LAS u32x4*)(lds + pkw[i] + vswz) = pv[i]; }
        bf16x8 qf[4];
#pragma unroll
        for (int ks = 0; ks < 4; ++ks) qf[ks] = pq[ks];
        if (tid == 0) { slot[0] = (int)__hip_atomic_fetch_add(qctr, 1u, __ATOMIC_RELAXED, __HIP_MEMORY_SCOPE_AGENT); asm volatile("s_waitcnt vmcnt(0)" ::: "memory"); }
        asm volatile("s_waitcnt lgkmcnt(0)" ::: "memory"); __builtin_amdgcn_s_barrier(); asm volatile("" ::: "memory");
        const int nbu = slot[0];
        if (nbu < 1536) ATT_FETCH(nbu);
        const int grp = grp0_ + wave;
        const int tq = rho_ + ((32 * grp + n) << dsh_);
        const float sd = __builtin_amdgcn_exp2f(-0.5f * (float)(h_ + 1)) * LOG2E * (float)(1 << dsh_);
        const float sd32 = 32.0f * sd;
        f32x16 o0, o1, lacc, aci;
#pragma unroll
        for (int i = 0; i < 16; ++i) { o0[i] = 0.f; o1[i] = 0.f; lacc[i] = 0.f; aci[i] = sd * (float)((i & 3) + 8 * (i >> 2) + 4 * hh); }
        float m = -1e30f;
        const int ktmin = grp >= 4 ? 0 : 4 - grp;
        LAS unsigned char* wt = lds + wave * 8192;
#define ATT_TR(addr) __builtin_amdgcn_ds_read_tr16_b64_v4i16((LAS v4i16_t*)(addr))
#define ATT_PV2(tb, pf0, pf1) do { \
        const v4i16_t l00 = ATT_TR((tb) + vb[0]), h00 = ATT_TR((tb) + vb[0] + 1024), l01 = ATT_TR((tb) + vb[1]), h01 = ATT_TR((tb) + vb[1] + 1024); \
        const v4i16_t l10 = ATT_TR((tb) + 2048 + vb[0]), h10 = ATT_TR((tb) + 2048 + vb[0] + 1024), l11 = ATT_TR((tb) + 2048 + vb[1]), h11 = ATT_TR((tb) + 2048 + vb[1] + 1024); \
        o0 = MFMA32(__builtin_shufflevector(l00, h00, 0, 1, 2, 3, 4, 5, 6, 7), pf0, o0); o1 = MFMA32(__builtin_shufflevector(l01, h01, 0, 1, 2, 3, 4, 5, 6, 7), pf0, o1); lacc = MFMA32(ones, pf0, lacc); \
        o0 = MFMA32(__builtin_shufflevector(l10, h10, 0, 1, 2, 3, 4, 5, 6, 7), pf1, o0); o1 = MFMA32(__builtin_shufflevector(l11, h11, 0, 1, 2, 3, 4, 5, 6, 7), pf1, o1); lacc = MFMA32(ones, pf1, lacc); } while (0)
        for (int kt = 4; kt >= ktmin; kt -= 2) {
            const bool hasB = (kt - 1 >= ktmin);
            LAS unsigned char* tA = wt + kt * 8192; LAS unsigned char* tB = tA - 8192;
            f32x16 x0 = aci, x1 = aci;
#pragma unroll
            for (int ks = 0; ks < 4; ++ks) { const bf16x8 kf = *(const LAS bf16x8*)(tA + kr[ks]); x0 = MFMA32(kf, qf[ks], x0); }
            if (hasB) {
#pragma unroll
                for (int ks = 0; ks < 4; ++ks) { const bf16x8 kf = *(const LAS bf16x8*)(tB + kr[ks]); x1 = MFMA32(kf, qf[ks], x1); }
            } else {
#pragma unroll
                for (int rg = 0; rg < 16; ++rg) x1[rg] = -INFINITY;
            }
            if (kt == 4) {
#pragma unroll
                for (int rg = 0; rg < 16; ++rg) { const int cr = (rg & 3) + 8 * (rg >> 2) + 4 * hh; x0[rg] = (cr <= n) ? x0[rg] : -INFINITY; }
            } else if (kt == 0) {
#pragma unroll
                for (int rg = 0; rg < 16; ++rg) { const int cr = (rg & 3) + 8 * (rg >> 2) + 4 * hh; x0[rg] = (cr >= n) ? x0[rg] : -INFINITY; }
            }
            float tmax = fmaxf(fmaxf(x0[0], x0[1]), fmaxf(x0[2], x0[3])), tmb = fmaxf(fmaxf(x1[0], x1[1]), fmaxf(x1[2], x1[3]));
#pragma unroll
            for (int rg = 4; rg < 16; rg += 4) { tmax = fmaxf(tmax, fmaxf(fmaxf(x0[rg], x0[rg + 1]), fmaxf(x0[rg + 2], x0[rg + 3]))); tmb = fmaxf(tmb, fmaxf(fmaxf(x1[rg], x1[rg + 1]), fmaxf(x1[rg + 2], x1[rg + 3]))); }
            tmax = fmaxf(tmax, tmb - sd32);
            { auto rr = __builtin_amdgcn_permlane32_swap(__float_as_uint(tmax), __float_as_uint(tmax), false, false);
              tmax = fmaxf(__uint_as_float(rr[0]), __uint_as_float(rr[1])); }
            const float c0 = sd32 * (float)kt;
            const float mn = fmaxf(m, tmax + c0);
            if (__builtin_amdgcn_ballot_w64(mn > m) != 0ull) {
                const float alpha = __builtin_amdgcn_exp2f(m - mn);
#pragma unroll
                for (int i = 0; i < 16; ++i) { o0[i] *= alpha; o1[i] *= alpha; lacc[i] *= alpha; }
                m = mn;
            }
            const float mm = m - c0, mmB = mm + sd32;
            bf16x8 pA[2], pB[2];
#pragma unroll
            for (int s2 = 0; s2 < 2; ++s2) { u32x4 pw;
                pw.x = cvtpk(__builtin_amdgcn_exp2f(x0[8 * s2] - mm), __builtin_amdgcn_exp2f(x0[8 * s2 + 1] - mm)); pw.y = cvtpk(__builtin_amdgcn_exp2f(x0[8 * s2 + 2] - mm), __builtin_amdgcn_exp2f(x0[8 * s2 + 3] - mm));
                pw.z = cvtpk(__builtin_amdgcn_exp2f(x0[8 * s2 + 4] - mm), __builtin_amdgcn_exp2f(x0[8 * s2 + 5] - mm)); pw.w = cvtpk(__builtin_amdgcn_exp2f(x0[8 * s2 + 6] - mm), __builtin_amdgcn_exp2f(x0[8 * s2 + 7] - mm));
                pA[s2] = __builtin_bit_cast(bf16x8, pw); }
            ATT_PV2(tA, pA[0], pA[1]);
            if (hasB) {
#pragma unroll
                for (int s2 = 0; s2 < 2; ++s2) { u32x4 pw;
                    pw.x = cvtpk(__builtin_amdgcn_exp2f(x1[8 * s2] - mmB), __builtin_amdgcn_exp2f(x1[8 * s2 + 1] - mmB)); pw.y = cvtpk(__builtin_amdgcn_exp2f(x1[8 * s2 + 2] - mmB), __builtin_amdgcn_exp2f(x1[8 * s2 + 3] - mmB));
                    pw.z = cvtpk(__builtin_amdgcn_exp2f(x1[8 * s2 + 4] - mmB), __builtin_amdgcn_exp2f(x1[8 * s2 + 5] - mmB)); pw.w = cvtpk(__builtin_amdgcn_exp2f(x1[8 * s2 + 6] - mmB), __builtin_amdgcn_exp2f(x1[8 * s2 + 7] - mmB));
                    pB[s2] = __builtin_bit_cast(bf16x8, pw); }
                ATT_PV2(tB, pB[0], pB[1]);
            }
        }
#undef ATT_PV2
#undef ATT_TR
        const float lt = lacc[0];
        const float inv = __builtin_amdgcn_rcpf(lt);
        bf16_t* OP = OPB + (size_t)p_ * PROJ_STRIDE; float* LSE = LSEB + (size_t)p_ * S * 16;
        if (hh == 0) LSE[(size_t)tq * 16 + h_] = m + __builtin_amdgcn_logf(lt) - sd * (float)(n + 128);
        u32x2 pk8[8];
#pragma unroll
        for (int dt = 0; dt < 2; ++dt)
#pragma unroll
            for (int g = 0; g < 4; ++g) {
                float v0, v1, v2, v3;
                if (dt == 0) { v0 = o0[4 * g]; v1 = o0[4 * g + 1]; v2 = o0[4 * g + 2]; v3 = o0[4 * g + 3]; } else { v0 = o1[4 * g]; v1 = o1[4 * g + 1]; v2 = o1[4 * g + 2]; v3 = o1[4 * g + 3]; }
                pk8[4 * dt + g].x = cvtpk(v0 * inv, v1 * inv); pk8[4 * dt + g].y = cvtpk(v2 * inv, v3 * inv); }
        bf16_t* orow = OP + (size_t)tq * 1024 + h_ * 64 + 8 * hh;
#pragma unroll
        for (int k = 0; k < 8; k += 2) {
            auto rx = __builtin_amdgcn_permlane32_swap(pk8[k].x, pk8[k + 1].x, false, false);
            auto ry = __builtin_amdgcn_permlane32_swap(pk8[k].y, pk8[k + 1].y, false, false);
            u32x4 w; w.x = rx[0]; w.y = ry[0]; w.z = rx[1]; w.w = ry[1];
            *(u32x4*)(orow + 8 * k) = w; }
            bu = nbu;
    }
#undef ATT_DECODE
#undef ATT_FETCH
    asm volatile("s_waitcnt lgkmcnt(0)" ::: "memory"); __builtin_amdgcn_s_barrier();
}

constexpr int LRU_WL = 17408;
__device__ __forceinline__ void lru_unit(LAS unsigned char* wl, const bf16_t* __restrict__ U, const bf16_t* __restrict__ GL, const bf16_t* __restrict__ WRT, const bf16_t* __restrict__ WIT,
                                         const float* __restrict__ conv_w, const float* __restrict__ conv_b, const float* __restrict__ b_r, const float* __restrict__ b_i,
                                         const float* __restrict__ lam, unsigned long long* TOT, bf16_t* __restrict__ MX, int c, int nb, int lane) {
    unsigned long long* TOT2 = TOT - (WS_TOT - WS_TOT2) / 8;
    const int t0 = 64 * c, ch0 = 64 * nb;
    const int rs = lane >> 3, chn = lane & 7;
    LAS unsigned char* xcb = wl + 9216;
#pragma unroll
    for (int i = 0; i < 9; ++i) { const int row = 8 * i + rs; const int tok = t0 - 3 + row;
        u32x4 v = (u32x4){0u, 0u, 0u, 0u};
        if (row < 67 && tok >= 0) v = __builtin_nontemporal_load((const u32x4*)(U + (size_t)tok * 1024 + ch0 + 8 * chn));
        *(LAS u32x4*)(wl + row * 128 + chn * 16) = v; }
    {
    float cw[4][8], cbv[8];
    { const float* wp = conv_w + ch0 + 8 * chn;
#pragma unroll
      for (int j = 0; j < 4; ++j) { const f32x4 a = *(const f32x4*)(wp + j * 1024), b = *(const f32x4*)(wp + j * 1024 + 4);
          cw[j][0] = a[0]; cw[j][1] = a[1]; cw[j][2] = a[2]; cw[j][3] = a[3]; cw[j][4] = b[0]; cw[j][5] = b[1]; cw[j][6] = b[2]; cw[j][7] = b[3]; }
      const f32x4 a = *(const f32x4*)(conv_b + ch0 + 8 * chn), b = *(const f32x4*)(conv_b + ch0 + 8 * chn + 4);
      cbv[0] = a[0]; cbv[1] = a[1]; cbv[2] = a[2]; cbv[3] = a[3]; cbv[4] = b[0]; cbv[5] = b[1]; cbv[6] = b[2]; cbv[7] = b[3]; }
    LDS_WAIT();
#pragma unroll 2
    for (int i = 0; i < 8; ++i) { const int t = 8 * i + rs;
        float xo[8];
#pragma unroll
        for (int e = 0; e < 8; ++e) xo[e] = cbv[e];
#pragma unroll
        for (int j = 0; j < 4; ++j) { const u32x4 uv = *(const LAS u32x4*)(wl + (t + j) * 128 + chn * 16);
            xo[0] += cw[j][0] * bflo(uv.x); xo[1] += cw[j][1] * bfhi(uv.x); xo[2] += cw[j][2] * bflo(uv.y); xo[3] += cw[j][3] * bfhi(uv.y);
            xo[4] += cw[j][4] * bflo(uv.z); xo[5] += cw[j][5] * bfhi(uv.z); xo[6] += cw[j][6] * bflo(uv.w); xo[7] += cw[j][7] * bfhi(uv.w); }
        u32x4 w; w.x = cvtpk(xo[0], xo[1]); w.y = cvtpk(xo[2], xo[3]); w.z = cvtpk(xo[4], xo[5]); w.w = cvtpk(xo[6], xo[7]);
        *(LAS u32x4*)(xcb + t * 128 + ((chn ^ ((t >> 1) & 7)) << 4)) = w; }
    LDS_WAIT();
    }
    {
        u32x4 gv[8];
#pragma unroll
        for (int i = 0; i < 8; ++i) gv[i] = *(const u32x4*)(GL + (size_t)(t0 + 8 * i + rs) * 1024 + ch0 + 8 * chn);
#pragma unroll
        for (int i = 0; i < 8; ++i) *(LAS u32x4*)(wl + (8 * i + rs) * 144 + chn * 16) = gv[i];
    }
    const int n = lane & 31, hh = lane >> 5;
#pragma unroll 1
    for (int jt = 0; jt < 2; ++jt) {
        const int chl = 32 * jt + n, ch = ch0 + chl;
        unsigned xb4[4];
#pragma unroll
        for (int q = 0; q < 4; ++q) { const int C = (q & 1) | ((q >> 1) << 2); xb4[q] = 9216u + hh * 512 + ((((chl >> 3) ^ (2 * hh)) ^ C) << 4) + (chl & 7) * 2; }
        bf16x8 bfr[2][4];
#pragma unroll
        for (int ks = 0; ks < 4; ++ks) { const size_t o = (size_t)nb * 4096 + (size_t)chl * 64 + 16 * ks + 8 * hh;
            bfr[0][ks] = *(const bf16x8*)(WRT + o); bfr[1][ks] = *(const bf16x8*)(WIT + o); }
        const float brv = b_r[ch], biv = b_i[ch], lsv = -8.0f * log1pf(expf(-lam[ch]));
        f32x16 av[2], bv[2];
        float s = 0.f, Atot = 1.f;
#pragma unroll
        for (int mt = 0; mt < 2; ++mt) {
            f32x16 ar, ai;
#pragma unroll
            for (int i = 0; i < 16; ++i) { ar[i] = 0.f; ai[i] = 0.f; }
            { const int row = 32 * mt + n;
#pragma unroll
              for (int ks = 0; ks < 4; ++ks) { const bf16x8 af = *(const LAS bf16x8*)(xcb + row * 128 + (((2 * ks + hh) ^ ((row >> 1) & 7)) << 4));
                  ar = MFMA32(af, bfr[0][ks], ar); ai = MFMA32(af, bfr[1][ks], ai); } }
#pragma unroll
            for (int rg = 0; rg < 16; ++rg) { const int tl = 32 * mt + (rg & 3) + 8 * (rg >> 2);
                const int q = (((rg >> 2) & 1) << 1) | ((rg & 3) >> 1);
                const float xc = bf2f(*(const LAS unsigned short*)(wl + xb4[q] + tl * 128));
                const float rr = fsigmoid(ar[rg] + brv); const float iv = fsigmoid(ai[rg] + biv);
                const float a_ = __expf(rr * lsv);
                const float b_ = __builtin_amdgcn_sqrtf(fmaxf(1.0f - a_ * a_, 0.f)) * iv * xc;
                ar[rg] = a_; ai[rg] = b_; }
            av[mt] = ar; bv[mt] = ai;
#pragma unroll
            for (int g = 0; g < 4; ++g) { float A = 1.f, B = 0.f;
#pragma unroll
                for (int e = 0; e < 4; ++e) { B = ar[4 * g + e] * B + ai[4 * g + e]; A = ar[4 * g + e] * A; }
                const float pA = __shfl_xor(A, 32), pB = __shfl_xor(B, 32);
                const float A0 = hh ? pA : A, B0 = hh ? pB : B, A1 = hh ? A : pA, B1 = hh ? B : pB;
                s = A1 * (A0 * s + B0) + B1; Atot = Atot * A0 * A1; }
        }
        if (hh == 0) { const unsigned long long gq = ((unsigned long long)__float_as_uint(s) << 32) | (unsigned long long)__float_as_uint(fmaxf(Atot, 1e-30f));
            __hip_atomic_store(TOT + (size_t)c * 1024 + ch, gq, __ATOMIC_RELAXED, __HIP_MEMORY_SCOPE_AGENT); }
        float fA = 1.f, fB = 0.f;
        {
            const int sc = c >> 4, rr_ = c & 15;
            const int cnt = hh ? rr_ : sc;
            unsigned long long* tp = hh ? (TOT + (size_t)(16 * sc) * 1024 + ch) : (TOT2 + ch);
            bool need_pub = (rr_ == 15);
            const float ownA = Atot, ownB = s;
            unsigned long long g[16];
            for (unsigned spins = 0;; ++spins) { bool ok = true;
#pragma unroll
                for (int k = 0; k < 16; ++k) { g[k] = 0x3f800000ull;
                    if (k < cnt) { g[k] = __hip_atomic_load(tp + (size_t)k * 1024, __ATOMIC_RELAXED, __HIP_MEMORY_SCOPE_AGENT); ok = ok && ((unsigned)g[k] != 0u); } }
                const unsigned long long okm = __builtin_amdgcn_ballot_w64(ok);
                if (need_pub && (unsigned)(okm >> 32) == 0xffffffffu) {
                    float tA = 1.f, tB = 0.f;
#pragma unroll
                    for (int k = 0; k < 16; ++k) { const float A = __uint_as_float((unsigned)g[k]), B = __uint_as_float((unsigned)(g[k] >> 32)); tB = A * tB + B; tA = A * tA; }
                    if (hh) { const unsigned long long gq = ((unsigned long long)__float_as_uint(ownA * tB + ownB) << 32) | (unsigned long long)__float_as_uint(fmaxf(ownA * tA, 1e-30f));
                        __hip_atomic_store(TOT2 + (size_t)sc * 1024 + ch, gq, __ATOMIC_RELAXED, __HIP_MEMORY_SCOPE_AGENT); }
                    need_pub = false;
                }
                if (okm == ~0ull || spins > (1u << 20)) break;
                __builtin_amdgcn_s_sleep(4);
            }
#pragma unroll
            for (int k = 0; k < 16; ++k) { const float A = __uint_as_float((unsigned)g[k]), B = __uint_as_float((unsigned)(g[k] >> 32)); fB = A * fB + B; fA = A * fA; }
        }
        s = __shfl(fA, 32 + n) * __shfl(fB, n) + __shfl(fB, 32 + n);
#pragma unroll
        for (int mt = 0; mt < 2; ++mt) {
            float sin_[4];
#pragma unroll
            for (int g = 0; g < 4; ++g) { float A = 1.f, B = 0.f;
#pragma unroll
                for (int e = 0; e < 4; ++e) { B = av[mt][4 * g + e] * B + bv[mt][4 * g + e]; A = av[mt][4 * g + e] * A; }
                const float pA = __shfl_xor(A, 32), pB = __shfl_xor(B, 32);
                const float A0 = hh ? pA : A, B0 = hh ? pB : B, A1 = hh ? A : pA, B1 = hh ? B : pB;
                const float mid = A0 * s + B0; sin_[g] = hh ? mid : s; s = A1 * mid + B1; }
            LAS unsigned char* gbase = wl + (4 * hh) * 144 + chl * 2;
#pragma unroll
            for (int g = 0; g < 4; ++g) { float hv = sin_[g];
#pragma unroll
                for (int e = 0; e < 4; ++e) { const int rg = 4 * g + e; hv = av[mt][rg] * hv + bv[mt][rg];
                    LAS unsigned short* gp = (LAS unsigned short*)(gbase + (32 * mt + e + 8 * g) * 144);
                    const float ov = hv * fsilu(bf2f(*gp));
                    *gp = (unsigned short)(cvtpk(ov, 0.f) & 0xffffu); } }
        }
    }
    LDS_WAIT();
#pragma unroll
    for (int i = 0; i < 8; ++i) { const u32x4 v = *(const LAS u32x4*)(wl + (8 * i + rs) * 144 + chn * 16);
        __builtin_amdgcn_raw_buffer_store_b128(v, __builtin_amdgcn_make_buffer_rsrc((void*)MX, (short)0, (int)((size_t)S * 2048 * 2), 0x00020000), (int)(((size_t)(t0 + 8 * i + rs) * 2048 + 1024 + ch0 + 8 * chn) * 2), 0, 16); }
    LDS_WAIT();
}

#define XB_TMO      128
#define XB_XCNT(j)  (256  + 64 * (j))
#define XB_XSUB(j)  (1280 + 64 * (j))
#define XB_XGEN(j)  (2304 + 64 * (j))
#define XB_TOP      3328
#define XB_TOPGEN   3392
#define XCD_BAR_WORDS 3456
#define XB_SPIN_CAP (1u << 18)
__device__ __forceinline__ unsigned xb_ld(unsigned* p)              { return __hip_atomic_load(p, __ATOMIC_RELAXED, __HIP_MEMORY_SCOPE_AGENT); }
__device__ __forceinline__ unsigned xb_add(unsigned* p, unsigned v) { return __hip_atomic_fetch_add(p, v, __ATOMIC_RELAXED, __HIP_MEMORY_SCOPE_AGENT); }
__device__ __forceinline__ unsigned xb_xcc_id() { return (unsigned)__builtin_amdgcn_s_getreg((3 << 11) | 20) & 0xFu; }
#define XB_SPIN(cond, bar) do { unsigned _sp = 0; while (cond) { __builtin_amdgcn_s_sleep(1); \
    if ((++_sp & 255u) == 0u) { if (xb_ld(&(bar)[XB_TMO])) break; if (_sp > XB_SPIN_CAP) { atomicAdd(&(bar)[XB_TMO], 1u); break; } } } } while (0)
struct XcdBarrier { unsigned* bar; unsigned x; volatile LAS unsigned* st; };
__device__ __forceinline__ XcdBarrier xcd_barrier_post(unsigned* bar, volatile LAS unsigned* st) {
    XcdBarrier b; b.bar = bar; b.x = xb_xcc_id(); b.st = st;
    if (threadIdx.x == 0) (void)xb_add(&bar[XB_XCNT(b.x)], 1u);
    return b;
}
__device__ __forceinline__ void xcd_barrier_complete(unsigned* bar, unsigned x, unsigned& nloc, unsigned& nx) {
    const unsigned G = gridDim.x * gridDim.y * gridDim.z;
    unsigned sum, cnt, mine, sp = 0u;
    for (;;) {
        sum = 0u; cnt = 0u; mine = 0u;
#pragma unroll
        for (unsigned j = 0; j < 16; ++j) { const unsigned c = xb_ld(&bar[XB_XCNT(j)]); sum += c; cnt += (c > 0u) ? 1u : 0u; mine = (j == x) ? c : mine; }
        if (sum == G) break;
        __builtin_amdgcn_s_sleep(1);
        if ((++sp & 255u) == 0u) { if (xb_ld(&bar[XB_TMO])) break; if (sp > XB_SPIN_CAP) { atomicAdd(&bar[XB_TMO], 1u); break; } }
    }
    nloc = mine > 0u ? mine : 1u; nx = cnt > 0u ? cnt : 1u;
}
__device__ __forceinline__ void xcd_barrier(const XcdBarrier& b) {
    asm volatile("s_waitcnt vmcnt(0)" ::: "memory");
    __syncthreads();
    if (threadIdx.x == 0) {
        unsigned* bar = b.bar;
        __builtin_amdgcn_s_waitcnt(0);
        unsigned nloc = b.st[0], nx = b.st[1];
        if (nloc == 0u) { xcd_barrier_complete(bar, b.x, nloc, nx); b.st[0] = nloc; b.st[1] = nx; }
        const unsigned old = xb_add(&bar[XB_XSUB(b.x)], 1u);
        const unsigned gen = old / nloc;
        if (old + 1u == (gen + 1u) * nloc) {
            __builtin_amdgcn_fence(__ATOMIC_RELEASE, "agent");
            asm volatile("s_waitcnt vmcnt(0)" ::: "memory");
            const unsigned og = xb_add(&bar[XB_TOP], 1u);
            const unsigned tg = og / nx;
            if (og + 1u == (tg + 1u) * nx) xb_add(&bar[XB_TOPGEN], 1u);
            else XB_SPIN(xb_ld(&bar[XB_TOPGEN]) == tg, bar);
            __builtin_amdgcn_fence(__ATOMIC_ACQUIRE, "agent");
            xb_add(&bar[XB_XGEN(b.x)], 1u);
            asm volatile("s_waitcnt vmcnt(0)" ::: "memory");
        } else {
            XB_SPIN(xb_ld(&bar[XB_XGEN(b.x)]) == gen, bar);
            __builtin_amdgcn_fence(__ATOMIC_ACQUIRE, "agent");
            asm volatile("s_waitcnt vmcnt(0)" ::: "memory");
        }
    }
    __syncthreads();
}

struct Args {
    const float *x, *c, *norm_gain, *w_ada, *b_ada, *w_in, *conv_w, *conv_b, *w_rgate, *b_rgate, *w_igate, *b_igate, *lru_lambda, *w_out, *final_gain;
    float* out; unsigned char* ws; int ph_lo, ph_hi, coop, pad;
};

__global__ void __launch_bounds__(NWAVES * 64, 2) hymba_fwd(Args a) {
    extern __shared__ __attribute__((aligned(16))) unsigned char lds_raw[];
    LAS unsigned char* lds = (LAS unsigned char*)lds_raw;
    const int tid = threadIdx.x, lane = tid & 63, wave = __builtin_amdgcn_readfirstlane(tid >> 6);
    const int G = gridDim.x; const int bx = blockIdx.x;
    const int vcu = (G % 8 == 0) ? (bx % 8) * (G / 8) + bx / 8 : bx;
    const int gw = vcu * NWAVES + wave, NGW = G * NWAVES;
    unsigned char* ws = a.ws;
    float* mod = (float*)(ws + WS_MOD);
    bf16_t* WRT = (bf16_t*)(ws + WS_WRT); bf16_t* WIT = (bf16_t*)(ws + WS_WIT);
    unsigned long long* TOT = (unsigned long long*)(ws + WS_TOT);
    bf16_t* WIN = (bf16_t*)(ws + WS_WIN); bf16_t* WOUT = (bf16_t*)(ws + WS_WOUT);
    bf16_t* HB = (bf16_t*)(ws + WS_H); bf16_t* MX = HB;
    bf16_t* PJ = (bf16_t*)(ws + WS_PROJ);
    bf16_t* OPB = (bf16_t*)(ws + WS_OP); float* LSEB = (float*)(ws + WS_LSE);
    const int lo = a.ph_lo, hi = a.ph_hi;
    volatile LAS unsigned* xst = (volatile LAS unsigned*)(lds + 143360);
    if (tid < 2) xst[tid] = 0u;
    __syncthreads();
    XcdBarrier xbar; xbar.bar = (unsigned*)ws; xbar.x = 0; xbar.st = xst;
    if (a.coop == 1) xbar = xcd_barrier_post((unsigned*)ws, xst);
#define IN(k) (lo <= (k) && (k) < hi)
#ifndef REP_A
#define REP_A 1
#endif
#ifndef REP_B
#define REP_B 1
#endif
#ifndef REP_S
#define REP_S 1
#endif
#ifndef REP_G
#define REP_G 1
#endif
#ifndef REP_H
#define REP_H 1
#endif
#define SEAM(k) do { if (a.coop && IN(k) && IN((k) + 1)) { for (int rs_ = 0; rs_ < REP_S; ++rs_) { xcd_barrier(xbar); } } } while (0)

    for (int rep_ = 0; rep_ < REP_A; ++rep_) if (IN(0)) {
        { unsigned long long* z = (unsigned long long*)(ws + WS_TOT); const size_t me = (size_t)bx * (NWAVES * 64) + tid, T = (size_t)G * (NWAVES * 64);
          for (size_t q = me; q < (size_t)128 * 1024; q += T) z[q] = 0ull;
          unsigned long long* z2 = (unsigned long long*)(ws + WS_TOT2);
          for (size_t q = me; q < (size_t)8 * 1024; q += T) z2[q] = 0ull; }
        for (int grp = bx; grp < PW / 32; grp += G) {
            const int sub = lane >> 3, ch = lane & 7;
            f32x4 acc = (f32x4){0.f, 0.f, 0.f, 0.f};
            const float* wp = a.w_ada + (size_t)(256 * wave + sub) * PW + 32 * grp + 4 * ch;
#pragma unroll 8
            for (int i = 0; i < 32; ++i) { const float cv = a.c[256 * wave + 8 * i + sub]; const float ca = cv * fsigmoid(cv);
                const f32x4 w4 = __builtin_nontemporal_load((const f32x4*)(wp + (size_t)(8 * i) * PW)); acc += ca * w4; }
#pragma unroll
            for (int e = 0; e < 4; ++e) { float v = acc[e]; v += __shfl_xor(v, 8); v += __shfl_xor(v, 16); v += __shfl_xor(v, 32); acc[e] = v; }
            LAS float* red = (LAS float*)lds;
            if (lane < 8) {
#pragma unroll
                for (int e = 0; e < 4; ++e) red[wave * 32 + 4 * lane + e] = acc[e]; }
            __syncthreads();
            if (tid < 32) { float s = a.b_ada[32 * grp + tid];
#pragma unroll
                for (int w = 0; w < 8; ++w) s += red[w * 32 + tid];
                mod[32 * grp + tid] = s; }
            __syncthreads();
        }
        LAS float* scr = (LAS float*)(lds + wave * 16384);
        constexpr int I_IN = (DM / 64) * (PW / 32), I_OUT = (DM / 64) * (DM / 32), I_G = 32;
        const int ngv = (PW / 32) < G ? (PW / 32) : G;
        const int NV = ngv * NWAVES + (G - ngv) * NWAVES * 2;
        const int nv = bx < ngv ? 1 : 2, vw0 = bx < ngv ? bx * NWAVES + wave : ngv * NWAVES + (bx - ngv) * NWAVES * 2 + wave * 2;
        for (int v = 0; v < nv; ++v)
        for (int it = vw0 + v; it < I_IN + I_OUT + 2 * I_G; it += NV) {
            int r = it;
            if (r < I_IN) { transpose_item(a.w_in, DM, PW, WIN, scr, r, lane); continue; } r -= I_IN;
            if (r < I_OUT) { transpose_item(a.w_out, DM, DM, WOUT, scr, r, lane); continue; } r -= I_OUT;
            if (r < I_G) { transpose_item(a.w_rgate + (size_t)(r >> 1) * 4096, 64, 64, WRT + (size_t)(r >> 1) * 4096, scr, r & 1, lane); continue; } r -= I_G;
            transpose_item(a.w_igate + (size_t)(r >> 1) * 4096, 64, 64, WIT + (size_t)(r >> 1) * 4096, scr, r & 1, lane);
        }
    }
    SEAM(0);
    for (int rep_ = 0; rep_ < REP_A; ++rep_) if (IN(1)) {
        f32x4 gs[8], sh[8];
#pragma unroll
        for (int j = 0; j < 8; ++j) { const int col = 4 * lane + 256 * j; const f32x4 g = *(const f32x4*)(a.norm_gain + col); const f32x4 sc = *(const f32x4*)(mod + DM + col);
            gs[j] = g * (sc + 1.0f); sh[j] = *(const f32x4*)(mod + col); }
        for (int row = gw; row < S; row += NGW) {
            const f32x4* xr = (const f32x4*)(a.x + (size_t)row * DM) + lane;
            f32x4 v[8]; float ss = 0.f;
#pragma unroll
            for (int j = 0; j < 8; ++j) { v[j] = __builtin_nontemporal_load(xr + 64 * j); ss += (v[j].x * v[j].x + v[j].y * v[j].y) + (v[j].z * v[j].z + v[j].w * v[j].w); }
            const float rstd = rsqrtf(wave_sum(ss) * (1.0f / DM) + EPS);
            u32x2* o8 = (u32x2*)(HB + (size_t)row * DM) + lane;
#pragma unroll
            for (int j = 0; j < 8; ++j) { const f32x4 hv = v[j] * rstd * gs[j] + sh[j]; u32x2 w; w.x = cvtpk(hv.x, hv.y); w.y = cvtpk(hv.z, hv.w); o8[64 * j] = w; }
        }
    }
    SEAM(1);
    for (int rep_ = 0; rep_ < REP_G; ++rep_) if (IN(2)) {
        pg8::Gemm g{HB, WIN, S, PW, DM}; pg8::StaticOrder So; So.init(S, PW, G, bx);
        pg8::EpiBf16 E{PJ, 1024, 1024, PROJ_STRIDE, QSCALE};
        pg8::gemm_phase<pg8::EpiBf16, pg8::StaticOrder, true, true>(lds, g, So, E);
    }
    SEAM(2);
    for (int rep_ = 0; rep_ < REP_B; ++rep_) if (IN(3)) {
        { LAS unsigned char* wl = lds + wave * LRU_WL;
          for (int u = gw; u < 128 * 16; u += NGW) lru_unit(wl, PJ + 4 * PROJ_STRIDE, PJ + 5 * PROJ_STRIDE, WRT, WIT, a.conv_w, a.conv_b, a.b_rgate, a.b_igate, a.lru_lambda, TOT, MX, u >> 4, u & 15, lane); }
        __syncthreads();
        attn_phase(lds, PJ, PJ + PROJ_STRIDE, PJ + 2 * PROJ_STRIDE, OPB, LSEB, (unsigned*)ws + 8192, wave, lane, tid);
    }
    SEAM(3);
    for (int rep_ = 0; rep_ < REP_B; ++rep_) if (IN(4)) {
        const bf16_t* GA = PJ + 3 * PROJ_STRIDE;
        for (int e = gw * 64 + lane; e < S * 128; e += NGW * 64) { const int t = e >> 7, c8 = e & 127, hd = c8 >> 3;
            const float l0 = LSEB[(size_t)t * 16 + hd], l1 = LSEB[(size_t)S * 16 + (size_t)t * 16 + hd], l2 = LSEB[(size_t)2 * S * 16 + (size_t)t * 16 + hd];
            const float mx = fmaxf(l0, fmaxf(l1, l2));
            float w0 = __builtin_amdgcn_exp2f(l0 - mx), w1 = __builtin_amdgcn_exp2f(l1 - mx), w2 = __builtin_amdgcn_exp2f(l2 - mx);
            const float wi = __builtin_amdgcn_rcpf(w0 + w1 + w2); w0 *= wi; w1 *= wi; w2 *= wi;
            const size_t off = (size_t)t * 1024 + 8 * c8;
            const u32x4 a0 = __builtin_nontemporal_load((const u32x4*)(OPB + off)), a1 = __builtin_nontemporal_load((const u32x4*)(OPB + PROJ_STRIDE + off)), a2 = __builtin_nontemporal_load((const u32x4*)(OPB + 2 * PROJ_STRIDE + off)), gg = __builtin_nontemporal_load((const u32x4*)(GA + off));
            u32x4 o;
#pragma unroll
            for (int k = 0; k < 4; ++k) { const float lo = (w0 * bflo(a0[k]) + w1 * bflo(a1[k]) + w2 * bflo(a2[k])) * fsilu(bflo(gg[k])); const float hi = (w0 * bfhi(a0[k]) + w1 * bfhi(a1[k]) + w2 * bfhi(a2[k])) * fsilu(bfhi(gg[k]));
                o[k] = cvtpk(lo, hi); }
            __builtin_amdgcn_raw_buffer_store_b128(o, __builtin_amdgcn_make_buffer_rsrc((void*)MX, (short)0, (int)((size_t)S * 2048 * 2), 0x00020000), (int)(((size_t)t * 2048 + 8 * c8) * 2), 0, 16); }
    }
    SEAM(4);
    const bool fused_final = (G == 256);
    if (IN(5)) {
        __syncthreads();
        pg8::Gemm g{MX, WOUT, S, DM, DM}; pg8::StaticOrder So; So.init(S, DM, G, bx);
        if (fused_final) {
            pg8::EpiFinal E{a.x, mod + 2 * DM, a.final_gain, a.out, DM, (float*)(ws + WS_SLOT), (unsigned*)ws + 4096};
            pg8::gemm_phase<pg8::EpiFinal, pg8::StaticOrder, false, true>(lds, g, So, E);
        } else {
            pg8::EpiResGate E{a.x, mod + 2 * DM, a.out, DM};
            pg8::gemm_phase<pg8::EpiResGate, pg8::StaticOrder, true, true>(lds, g, So, E);
        }
    }
    if (!fused_final) SEAM(5);
    if (IN(6) && !fused_final) {
        f32x4 fg[8];
#pragma unroll
        for (int j = 0; j < 8; ++j) fg[j] = *(const f32x4*)(a.final_gain + 4 * lane + 256 * j);
        for (int row = gw; row < S; row += NGW) {
            f32x4* yr = (f32x4*)(a.out + (size_t)row * DM) + lane;
            f32x4 v[8]; float ss = 0.f;
#pragma unroll
            for (int j = 0; j < 8; ++j) { v[j] = yr[64 * j]; ss += (v[j].x * v[j].x + v[j].y * v[j].y) + (v[j].z * v[j].z + v[j].w * v[j].w); }
            const float rstd = rsqrtf(wave_sum(ss) * (1.0f / DM) + EPS);
#pragma unroll
            for (int j = 0; j < 8; ++j) yr[64 * j] = v[j] * rstd * fg[j];
        }
    }
#undef IN
#undef SEAM
}

#ifndef MK_MULTI
#define MK_MULTI 0
#endif
extern "C" void kernel_launch(void* const* d_in, const int* in_sizes, int n_in, void* d_out, int out_size, void* d_ws, size_t ws_size, hipStream_t stream) {
    static int grid = 0;
    if (grid == 0) {
        int dev = 0, cus = 0, per_cu = 0;
        hipGetDevice(&dev);
        hipDeviceGetAttribute(&cus, hipDeviceAttributeMultiprocessorCount, dev);
        hipFuncSetAttribute((const void*)hymba_fwd, hipFuncAttributeMaxDynamicSharedMemorySize, LDS_BYTES);
        hipOccupancyMaxActiveBlocksPerMultiprocessor(&per_cu, (const void*)hymba_fwd, NWAVES * 64, LDS_BYTES);
        if (per_cu < 1) { fprintf(stderr, "kernel_launch: occupancy query returned %d\n", per_cu); per_cu = 1; }
        (void)hipGetLastError();
        grid = cus * per_cu;
    }
    (void)hipMemsetAsync(d_ws, 0, 40960, stream);
    Args a{};
    a.x = (const float*)d_in[0]; a.c = (const float*)d_in[1]; a.norm_gain = (const float*)d_in[2]; a.w_ada = (const float*)d_in[3]; a.b_ada = (const float*)d_in[4];
    a.w_in = (const float*)d_in[5]; a.conv_w = (const float*)d_in[6]; a.conv_b = (const float*)d_in[7]; a.w_rgate = (const float*)d_in[8]; a.b_rgate = (const float*)d_in[9];
    a.w_igate = (const float*)d_in[10]; a.b_igate = (const float*)d_in[11]; a.lru_lambda = (const float*)d_in[12]; a.w_out = (const float*)d_in[13]; a.final_gain = (const float*)d_in[14];
    a.out = (float*)d_out; a.ws = (unsigned char*)d_ws; a.pad = 0;
#if MK_MULTI
    for (int p = 0; p < NPH; ++p) { a.ph_lo = p; a.ph_hi = p + 1; a.coop = 0; hipLaunchKernelGGL(hymba_fwd, dim3(grid), dim3(NWAVES * 64), LDS_BYTES, stream, a); }
#else
    a.ph_lo = 0; a.ph_hi = NPH; a.coop = 1;
    void* args[] = {&a};
    hipError_t e = hipLaunchCooperativeKernel((const void*)hymba_fwd, dim3(grid), dim3(NWAVES * 64), args, LDS_BYTES, stream);
    if (e != hipSuccess) fprintf(stderr, "launch failed: %s (grid %d)\n", hipGetErrorString(e), grid);
#endif
}
```
